# Optimizing an MI355X kernel written in HIP

```python
import math
import jax, jax.numpy as jnp
from jax import lax
import numpy as np

D_MODEL = 2048
BATCH = 4
SEQ = 4096
DEPTH = 2

S5_WIDTH = D_MODEL // 2
S5_GROUP = 16
S5_GROUPS = S5_WIDTH // S5_GROUP
S5_STATE = 64
LRU_WIDTH = D_MODEL // 2
LRU_BLOCKS = 16
LRU_BLOCK = LRU_WIDTH // LRU_BLOCKS
CONV_WIDTH = 4
LRU_C = 8.0
HEAD_DIM = 128
N_HEADS = 8
ATTN_WIDTH = N_HEADS * HEAD_DIM
Q_BLOCK = 128
N_BRANCH = 3
D_FF = 4 * D_MODEL
IN_COLS = S5_WIDTH + LRU_WIDTH + 3 * ATTN_WIDTH + N_BRANCH * D_MODEL
EPS = 1e-6

kernel_name = "hybrid_s5_rglru_stickbreak_gated"


def rms_norm(x, g):
    x32 = x.astype(jnp.float32)
    y = x32 * lax.rsqrt(jnp.mean(x32 * x32, axis=-1, keepdims=True) + EPS)
    return (y * g.astype(jnp.float32)).astype(x.dtype)


def linear_scan(a, b):
    def combine(e1, e2):
        a1, b1 = e1
        a2, b2 = e2
        return (a1 * a2, a2 * b1 + b2)
    _, h = lax.associative_scan(combine, (a, b), axis=0)
    return h


def s5_branch(u, lam_re, lam_im, log_dt, b_re, b_im, c_re, c_im, d_skip, w_glu, b_glu):
    bsz, L, _ = u.shape
    u32 = u.astype(jnp.float32)
    dt = jnp.exp(log_dt.astype(jnp.float32))[:, None]
    lam = lax.complex(lam_re.astype(jnp.float32), lam_im.astype(jnp.float32))
    lam_bar = jnp.exp(lam * dt)
    b_mat = lax.complex(b_re.astype(jnp.float32), b_im.astype(jnp.float32))
    b_bar = ((lam_bar - 1.0) / lam)[..., None] * b_mat
    ug = u32.transpose(1, 0, 2).reshape(L, bsz, S5_GROUPS, S5_GROUP)
    bu = lax.complex(jnp.einsum('lbgc,gpc->lbgp', ug, jnp.real(b_bar)),
                     jnp.einsum('lbgc,gpc->lbgp', ug, jnp.imag(b_bar)))
    a = jnp.broadcast_to(lam_bar, (L, 1) + lam_bar.shape)
    h = linear_scan(a, bu)
    y = (jnp.einsum('lbgp,gcp->lbgc', jnp.real(h), c_re.astype(jnp.float32))
         - jnp.einsum('lbgp,gcp->lbgc', jnp.imag(h), c_im.astype(jnp.float32)))
    y = y.reshape(L, bsz, S5_WIDTH).transpose(1, 0, 2) + d_skip.astype(jnp.float32) * u32
    y = jax.nn.gelu(y)
    return y * jax.nn.sigmoid(y @ w_glu.astype(jnp.float32) + b_glu.astype(jnp.float32))


def causal_depthwise_conv(x, w, b):
    K = w.shape[0]
    L = x.shape[1]
    xp = jnp.pad(x, ((0, 0), (K - 1, 0), (0, 0)))
    out = b + xp[:, 0:L] * w[0]
    for kk in range(1, K):
        out = out + xp[:, kk:kk + L] * w[kk]
    return out


def rglru_branch(x, conv_w, conv_b, w_r, b_r, w_i, b_i, lam):
    bsz, L, _ = x.shape
    xc = causal_depthwise_conv(x, conv_w, conv_b).astype(jnp.float32)
    xb = xc.reshape(bsz, L, LRU_BLOCKS, LRU_BLOCK)
    r = jax.nn.sigmoid(jnp.einsum('blnj,njk->blnk', xb, w_r.astype(jnp.float32)) + b_r).reshape(bsz, L, LRU_WIDTH)
    i = jax.nn.sigmoid(jnp.einsum('blnj,njk->blnk', xb, w_i.astype(jnp.float32)) + b_i).reshape(bsz, L, LRU_WIDTH)
    log_a = -LRU_C * r * jax.nn.softplus(-lam.astype(jnp.float32))
    a = jnp.exp(log_a)
    gated = jnp.sqrt(-jnp.expm1(2.0 * log_a)) * (i * xc)
    h = linear_scan(a.transpose(1, 0, 2), gated.transpose(1, 0, 2))
    return h.transpose(1, 0, 2)


def stick_breaking_attention(q, k, v):
    bsz, L, H, Dh = q.shape
    nb = L // Q_BLOCK
    scale = Dh ** -0.5
    q_blocks = q.astype(jnp.float32).reshape(bsz, nb, Q_BLOCK, H, Dh).transpose(1, 0, 3, 2, 4)
    kh = k.astype(jnp.float32).transpose(0, 2, 1, 3)
    vh = v.astype(jnp.float32).transpose(0, 2, 1, 3)
    key_pos = jnp.arange(L)

    def one_block(args):
        qb, bi = args
        q_pos = bi * Q_BLOCK + jnp.arange(Q_BLOCK)
        z = jnp.einsum('bhqd,bhkd->bhqk', qb, kh) * scale
        causal = key_pos[None, :] < q_pos[:, None]
        log_keep = jnp.where(causal, jax.nn.log_sigmoid(-z), 0.0)
        log_stick = lax.cumsum(log_keep, axis=3, reverse=True) - log_keep
        w = jnp.where(causal, jnp.exp(jax.nn.log_sigmoid(z) + log_stick), 0.0)
        return jnp.einsum('bhqk,bhkd->bhqd', w, vh)

    out = lax.map(one_block, (q_blocks, jnp.arange(nb)))
    return out.transpose(1, 0, 3, 2, 4).reshape(bsz, L, H * Dh)


def hybrid_mixer(xn, w_in, b_gate,
                 s5_lam_re, s5_lam_im, s5_log_dt, s5_b_re, s5_b_im, s5_c_re, s5_c_im, s5_d, s5_w_glu, s5_b_glu,
                 lru_conv_w, lru_conv_b, lru_w_r, lru_b_r, lru_w_i, lru_b_i, lru_lambda,
                 w_br_s5, w_br_lru, w_br_attn, w_out):
    bsz, L, _ = xn.shape
    proj = xn @ w_in
    offs = [S5_WIDTH, S5_WIDTH + LRU_WIDTH, S5_WIDTH + LRU_WIDTH + ATTN_WIDTH,
            S5_WIDTH + LRU_WIDTH + 2 * ATTN_WIDTH, S5_WIDTH + LRU_WIDTH + 3 * ATTN_WIDTH]
    u_s5, u_lru, q, k, v, gate_logits = jnp.split(proj, offs, axis=-1)
    gates = jax.nn.sigmoid(gate_logits + b_gate)
    g_s5, g_lru, g_attn = jnp.split(gates, [D_MODEL, 2 * D_MODEL], axis=-1)

    y_s5 = s5_branch(u_s5, s5_lam_re, s5_lam_im, s5_log_dt, s5_b_re, s5_b_im, s5_c_re, s5_c_im,
                     s5_d, s5_w_glu, s5_b_glu)
    y_lru = rglru_branch(u_lru, lru_conv_w, lru_conv_b, lru_w_r, lru_b_r, lru_w_i, lru_b_i, lru_lambda)
    y_attn = stick_breaking_attention(q.reshape(bsz, L, N_HEADS, HEAD_DIM),
                                      k.reshape(bsz, L, N_HEADS, HEAD_DIM),
                                      v.reshape(bsz, L, N_HEADS, HEAD_DIM))
    merged = (g_s5 * (y_s5.astype(xn.dtype) @ w_br_s5)
              + g_lru * (y_lru.astype(xn.dtype) @ w_br_lru)
              + g_attn * (y_attn.astype(xn.dtype) @ w_br_attn))
    return merged @ w_out


def squared_relu_mlp(x, w_up, w_down):
    hdn = jax.nn.relu(x @ w_up)
    return (hdn * hdn) @ w_down


def setup_inputs(seed: int = 0) -> dict:
    key = jax.random.key(seed)
    ks = jax.random.split(key, 32)
    f32 = jnp.float32

    def nrm(k, shape, scale):
        return jax.random.normal(k, shape, f32) * scale

    x = jax.random.normal(ks[0], (BATCH, SEQ, D_MODEL), f32)
    norm_mix_g = 1.0 + nrm(ks[1], (DEPTH, D_MODEL), 0.01)
    w_in = nrm(ks[2], (DEPTH, D_MODEL, IN_COLS), D_MODEL ** -0.5)
    b_gate = nrm(ks[3], (DEPTH, N_BRANCH * D_MODEL), 0.01)
    n_idx = jnp.arange(S5_STATE, dtype=f32)
    s5_lam_re = -0.5 + nrm(ks[4], (DEPTH, S5_GROUPS, S5_STATE), 0.01)
    s5_lam_im = math.pi * n_idx[None, None, :] + nrm(ks[5], (DEPTH, S5_GROUPS, S5_STATE), 0.01)
    s5_log_dt = jax.random.uniform(ks[6], (DEPTH, S5_GROUPS), f32, math.log(1e-3), math.log(1e-1))
    s5_b_re = nrm(ks[7], (DEPTH, S5_GROUPS, S5_STATE, S5_GROUP), (2 * S5_GROUP) ** -0.5)
    s5_b_im = nrm(ks[8], (DEPTH, S5_GROUPS, S5_STATE, S5_GROUP), (2 * S5_GROUP) ** -0.5)
    s5_c_re = nrm(ks[9], (DEPTH, S5_GROUPS, S5_GROUP, S5_STATE), S5_STATE ** -0.5)
    s5_c_im = nrm(ks[10], (DEPTH, S5_GROUPS, S5_GROUP, S5_STATE), S5_STATE ** -0.5)
    s5_d = nrm(ks[11], (DEPTH, S5_WIDTH), 1.0)
    s5_w_glu = nrm(ks[12], (DEPTH, S5_WIDTH, S5_WIDTH), S5_WIDTH ** -0.5)
    s5_b_glu = nrm(ks[13], (DEPTH, S5_WIDTH), 0.01)
    lru_conv_w = nrm(ks[14], (DEPTH, CONV_WIDTH, LRU_WIDTH), CONV_WIDTH ** -0.5)
    lru_conv_b = nrm(ks[15], (DEPTH, LRU_WIDTH), 0.01)
    lru_w_r = nrm(ks[16], (DEPTH, LRU_BLOCKS, LRU_BLOCK, LRU_BLOCK), LRU_BLOCK ** -0.5)
    lru_b_r = nrm(ks[17], (DEPTH, LRU_BLOCKS, LRU_BLOCK), 0.01)
    lru_w_i = nrm(ks[18], (DEPTH, LRU_BLOCKS, LRU_BLOCK, LRU_BLOCK), LRU_BLOCK ** -0.5)
    lru_b_i = nrm(ks[19], (DEPTH, LRU_BLOCKS, LRU_BLOCK), 0.01)
    a_pow = jax.random.uniform(ks[20], (DEPTH, LRU_WIDTH), f32, 0.9, 0.999)
    a0 = a_pow ** (1.0 / LRU_C)
    lru_lambda = jnp.log(a0) - jnp.log1p(-a0)
    w_br_s5 = nrm(ks[21], (DEPTH, S5_WIDTH, D_MODEL), S5_WIDTH ** -0.5)
    w_br_lru = nrm(ks[22], (DEPTH, LRU_WIDTH, D_MODEL), LRU_WIDTH ** -0.5)
    w_br_attn = nrm(ks[23], (DEPTH, ATTN_WIDTH, D_MODEL), ATTN_WIDTH ** -0.5)
    w_out = nrm(ks[24], (DEPTH, D_MODEL, D_MODEL), D_MODEL ** -0.5)
    norm_mlp_g = 1.0 + nrm(ks[25], (DEPTH, D_MODEL), 0.01)
    w_up = nrm(ks[26], (DEPTH, D_MODEL, D_FF), D_MODEL ** -0.5)
    w_down = nrm(ks[27], (DEPTH, D_FF, D_MODEL), D_FF ** -0.5)
    final_norm_g = 1.0 + nrm(ks[28], (D_MODEL,), 0.01)
    return {"x": x, "norm_mix_g": norm_mix_g, "w_in": w_in, "b_gate": b_gate,
            "s5_lam_re": s5_lam_re, "s5_lam_im": s5_lam_im, "s5_log_dt": s5_log_dt,
            "s5_b_re": s5_b_re, "s5_b_im": s5_b_im, "s5_c_re": s5_c_re, "s5_c_im": s5_c_im,
            "s5_d": s5_d, "s5_w_glu": s5_w_glu, "s5_b_glu": s5_b_glu,
            "lru_conv_w": lru_conv_w, "lru_conv_b": lru_conv_b, "lru_w_r": lru_w_r, "lru_b_r": lru_b_r,
            "lru_w_i": lru_w_i, "lru_b_i": lru_b_i, "lru_lambda": lru_lambda,
            "w_br_s5": w_br_s5, "w_br_lru": w_br_lru, "w_br_attn": w_br_attn, "w_out": w_out,
            "norm_mlp_g": norm_mlp_g, "w_up": w_up, "w_down": w_down, "final_norm_g": final_norm_g}


def reference(x, norm_mix_g, w_in, b_gate,
              s5_lam_re, s5_lam_im, s5_log_dt, s5_b_re, s5_b_im, s5_c_re, s5_c_im,
              s5_d, s5_w_glu, s5_b_glu,
              lru_conv_w, lru_conv_b, lru_w_r, lru_b_r, lru_w_i, lru_b_i, lru_lambda,
              w_br_s5, w_br_lru, w_br_attn, w_out,
              norm_mlp_g, w_up, w_down, final_norm_g):
    h = x
    for l in range(DEPTH):
        xn = rms_norm(h, norm_mix_g[l])
        mixed = hybrid_mixer(xn, w_in[l], b_gate[l],
                             s5_lam_re[l], s5_lam_im[l], s5_log_dt[l], s5_b_re[l], s5_b_im[l],
                             s5_c_re[l], s5_c_im[l], s5_d[l], s5_w_glu[l], s5_b_glu[l],
                             lru_conv_w[l], lru_conv_b[l], lru_w_r[l], lru_b_r[l], lru_w_i[l],
                             lru_b_i[l], lru_lambda[l],
                             w_br_s5[l], w_br_lru[l], w_br_attn[l], w_out[l])
        h = h + mixed.astype(h.dtype)
        hn = rms_norm(h, norm_mlp_g[l])
        h = h + squared_relu_mlp(hn, w_up[l], w_down[l]).astype(h.dtype)
    return rms_norm(h, final_norm_g)
```

```cpp
#include <hip/hip_runtime.h>
#include <hip/hip_cooperative_groups.h>
#include <cstdio>
#include <cstdint>
namespace cg = cooperative_groups;

#define LAS __attribute__((address_space(3)))
typedef unsigned short bf16_t;
typedef short bf16x8 __attribute__((ext_vector_type(8)));
typedef float f32x4 __attribute__((ext_vector_type(4)));
typedef float f32x16 __attribute__((ext_vector_type(16)));
typedef unsigned u32x4 __attribute__((ext_vector_type(4)));
typedef unsigned u32x2 __attribute__((ext_vector_type(2)));

constexpr int T_TOK = 16384, SEQ = 4096, NB = 4, DM = 2048, DFF = 8192, INC = 11264;
constexpr float EPSN = 1e-6f;

constexpr size_t MiB = 1u << 20;
constexpr size_t OFF_PTAB = 0;
constexpr size_t OFF_KTAU = 1 * MiB;
constexpr size_t OFF_SUMA = 2 * MiB;
constexpr size_t OFF_SUMH = 3 * MiB;
constexpr size_t OFF_BAR = 5 * MiB;
constexpr size_t OFF_PART = 6 * MiB;
constexpr size_t OFF_RSTD = 4 * MiB + 65536;
constexpr size_t OFF_W = 8 * MiB;
constexpr size_t OFF_WIN = OFF_W;
constexpr size_t OFF_WGLU = OFF_WIN + 44 * MiB;
constexpr size_t OFF_WBR = OFF_WGLU + 2 * MiB;
constexpr size_t OFF_WOUT = OFF_WBR + 12 * MiB;
constexpr size_t OFF_WLRU = OFF_WOUT + 8 * MiB;
constexpr size_t OFF_M2 = OFF_WLRU + 4 * MiB;
constexpr size_t OFF_M13 = OFF_M2 + 8 * MiB;
constexpr size_t OFF_GATES = OFF_M13 + 12 * MiB;
constexpr size_t OFF_A5 = OFF_GATES + 192 * MiB;
constexpr size_t OFF_ULRU = OFF_A5 + 48 * MiB;
constexpr size_t OFF_XC = OFF_ULRU + 32 * MiB;
constexpr size_t OFF_SEND = OFF_XC + 32 * MiB;
constexpr size_t OFF_YPRE = OFF_SEND + 32 * MiB;
constexpr size_t OFF_YATT = OFF_YPRE + 32 * MiB;
constexpr size_t OFF_X2 = OFF_YATT + 32 * MiB;
constexpr size_t OFF_R3 = OFF_X2 + 64 * MiB;
constexpr size_t OFF_END = OFF_R3 + 128 * MiB;
constexpr size_t OFF_HDN = OFF_GATES;
static_assert(OFF_HDN + 256 * MiB <= OFF_X2, "hdn overlay");
static_assert(OFF_SEND - OFF_ULRU == OFF_YATT - OFF_SEND, "the three merge operands must be equally spaced");

typedef float f32x2_t __attribute__((ext_vector_type(2)));
typedef __bf16 bf16x2_t __attribute__((ext_vector_type(2)));
__device__ __forceinline__ unsigned cvt_pk_bf16(float lo, float hi) { f32x2_t v = {lo, hi}; bf16x2_t b = __builtin_convertvector(v, bf16x2_t); return __builtin_bit_cast(unsigned, b); }
__device__ __forceinline__ float bf2f(unsigned short b) { return __uint_as_float(((unsigned)b) << 16); }
__device__ __forceinline__ float bflo(unsigned w) { return __uint_as_float(w << 16); }
__device__ __forceinline__ float bfhi(unsigned w) { return __uint_as_float(w & 0xffff0000u); }
__device__ __forceinline__ unsigned short f2bf(float f) { unsigned u = __float_as_uint(f); return (unsigned short)((u + 0x7fffu + ((u >> 16) & 1u)) >> 16); }
__device__ __forceinline__ float sigmoid_f(float x) { return __builtin_amdgcn_rcpf(1.f + __expf(-x)); }
__device__ __forceinline__ int opaque(int v) { asm volatile("" : "+v"(v)); return v; }
__device__ __forceinline__ float wave_sum(float v) {
#pragma unroll
    for (int o = 1; o < 64; o <<= 1) v += __shfl_xor(v, o);
    return v;
}

namespace pg8 {
constexpr int BM = 256, BK = 64, HALF = 128, HTB = HALF * BK * 2, STAGE_BYTES = 8 * HTB, NXCD = 8, WGM = 2;
__host__ __device__ __forceinline__ int lds_byte(int r, int c) { const int st = (r >> 4) * 2 + (c >> 5), rr = r & 15, cc = c & 31, ob = rr * 64 + cc * 2; return st * 1024 + (ob ^ (((ob >> 9) & 1) << 5)); }
__host__ __device__ __forceinline__ void stage_rc(int b, int& R, int& C) { const int st = b / 1024, sb = b % 1024, swz = sb ^ (((sb >> 9) & 1) << 5); R = (st >> 1) * 16 + swz / 64; C = (st & 1) * 32 + (swz % 64) / 2; }
__host__ __device__ __forceinline__ int perm32(int rho) { const int n = rho >> 4, i = rho & 15; return 8 * (i >> 2) + 4 * n + (i & 3); }

struct Unit { int pm, pn, br; };
struct Gemm { const bf16_t* A; const bf16_t* Bt; int M, N, K, lda, ldb, akw; size_t astride; int bpan; };

struct StaticOrder {
    int nM, nN, nwg, G, c;
    __device__ void init(int M, int N, int G_, int c_) { nM = M / BM; nN = N / BM; nwg = nM * nN; G = G_; c = c_; }
    __device__ bool next(int i, Unit& u) const {
        const long L = (long)i * G + c; if (L >= nwg) return false;
        int wgid = (int)L; { const int q = nwg / NXCD, r = nwg % NXCD, xcd = wgid % NXCD, off = wgid / NXCD; wgid = (xcd < r ? xcd * (q + 1) : r * (q + 1) + (xcd - r) * q) + off; }
        const int nig = WGM * nN, gid = wgid / nig, fm = gid * WGM, gsz = (nM - fm) < WGM ? (nM - fm) : WGM;
        u.pm = fm + ((wgid % nig) % gsz); u.pn = (wgid % nig) / gsz; u.br = 0; return true;
    }
};
struct MergeOrder {
    StaticOrder so;
    __device__ void init(int M, int N, int G_, int c_) { so.init(M, N, G_, c_); }
    __device__ bool next(int i, Unit& u) const { if (!so.next(i / 3, u)) return false; u.br = i % 3; return true; }
};
struct BatchOrder {
    int G, c;
    __device__ void init(int G_, int c_) { G = G_; c = (G_ % 8 == 0) ? (c_ % 8) * (G_ / 8) + c_ / 8 : c_; }
    __device__ bool next(int i, Unit& u) const { const int L = i * G + c; if (L >= 256) return false; u.pm = L; u.pn = L >> 2; u.br = 0; return true; }
};

template <class Epi, class Sched, bool ALIGN_EPI = true, bool SP2 = true>
__device__ __forceinline__ void gemm_phase(LAS unsigned char* lds, const Gemm g, const Sched& S, const Epi& E) {
    const int tid = opaque((int)threadIdx.x), wid = __builtin_amdgcn_readfirstlane(tid >> 6), lane = tid & 63, wr = wid >> 2, wc = wid & 3, fr = lane & 15, fq = lane >> 4;
    int Kv = g.K; asm volatile("" : "+s"(Kv)); const int K = Kv, nt = K / BK;
    unsigned voffA[2], voffB[2];
#pragma unroll
    for (int i = 0; i < 2; ++i) { int R, C; stage_rc(tid * 16 + i * 8192, R, C); const int Rb = Epi::PERM ? ((R & ~31) + perm32(R & 31)) : R;
        voffA[i] = (unsigned)(R * g.lda + C) * 2u; voffB[i] = (unsigned)(Rb * g.ldb + C) * 2u; }
    const size_t kstep = (size_t)(BK * 2);
    const size_t hA = (size_t)HALF * g.lda * 2, hB = (size_t)HALF * g.ldb * 2;
    const size_t tA = 2 * hA, tB = 2 * hB;
    const unsigned ldsw = (unsigned)wid * 1024u;
    const int aoff = lds_byte(wr * 64 + fr, fq * 8), boff = lds_byte(wc * 32 + fr, fq * 8);
#define PG8_SA(b, h) (((b) * 2 + (h)) * HTB)
#define PG8_SB(b, h) ((4 + (b) * 2 + (h)) * HTB)
#define PG8_STAGE(bufoff, gbase, voff) do { _Pragma("unroll") for (int _i = 0; _i < 2; ++_i) \
        __builtin_amdgcn_global_load_lds((const unsigned*)((const char*)(gbase) + (voff)[_i]), (LAS unsigned*)(lds + (bufoff) + ldsw + _i * 8192), 16, 0, 0); } while (0)
#define PG8_LDA(dst, b, h) do { _Pragma("unroll") for (int m = 0; m < 4; ++m) _Pragma("unroll") for (int k = 0; k < 2; ++k) dst[m][k] = *(const LAS bf16x8*)(lds + PG8_SA(b, h) + aoff + m * 2048 + k * 1024); } while (0)
#define PG8_LDB(dst, b, h) do { _Pragma("unroll") for (int n = 0; n < 2; ++n) _Pragma("unroll") for (int k = 0; k < 2; ++k) dst[n][k] = *(const LAS bf16x8*)(lds + PG8_SB(b, h) + boff + n * 2048 + k * 1024); } while (0)
#define PG8_MMA(ai, bj, At, Bt) do { __builtin_amdgcn_s_setprio(1); _Pragma("unroll") for (int m = 0; m < 4; ++m) _Pragma("unroll") for (int n = 0; n < 2; ++n) _Pragma("unroll") for (int k = 0; k < 2; ++k) \
        acc[ai][bj][m][n] = __builtin_amdgcn_mfma_f32_16x16x32_bf16(Bt[n][k], At[m][k], acc[ai][bj][m][n], 0, 0, 0); __builtin_amdgcn_s_setprio(0); } while (0)
#define PG8_WAIT_V(n) asm volatile("s_waitcnt vmcnt(" #n ")" ::: "memory")
#define PG8_WAIT_L(n) asm volatile("s_waitcnt lgkmcnt(" #n ")" ::: "memory")
#define PG8_BAR __builtin_amdgcn_s_barrier()
#define PG8_SCHED __builtin_amdgcn_sched_barrier(0)
    Unit cur, nxt; int ui = 0;
    if (!S.next(0, cur)) return;
    f32x4 acc[2][2][4][2];
    if constexpr (Epi::INIT) E.init(acc, cur, wr, wc, fr, fq);
    else {
#pragma unroll
    for (int a = 0; a < 2; ++a)
#pragma unroll
        for (int b = 0; b < 2; ++b)
#pragma unroll
            for (int m = 0; m < 4; ++m)
#pragma unroll
                for (int n = 0; n < 2; ++n) acc[a][b][m][n] = (f32x4){0.f, 0.f, 0.f, 0.f};
    }
    bf16x8 At[4][2], B0[2][2], B1[2][2];
    const char* cA = (const char*)g.A + (size_t)cur.br * g.astride + (size_t)cur.pm * tA + (size_t)((cur.pn >> 1) * g.akw) * 2; const char* cB = (const char*)g.Bt + (size_t)(cur.br * g.bpan + cur.pn) * tB;
    if constexpr (SP2) {
        PG8_STAGE(PG8_SB(0, 0), cB, voffB); PG8_STAGE(PG8_SB(0, 1), cB + hB, voffB); PG8_STAGE(PG8_SA(0, 0), cA, voffA); PG8_STAGE(PG8_SA(0, 1), cA + hA, voffA);
        if (wr == 1) PG8_BAR;
        PG8_WAIT_V(2); PG8_BAR;
        PG8_STAGE(PG8_SB(1, 0), cB + kstep, voffB); PG8_STAGE(PG8_SA(1, 0), cA + kstep, voffA); PG8_STAGE(PG8_SB(1, 1), cB + hB + kstep, voffB);
        PG8_WAIT_V(6); PG8_BAR;
    } else {
        PG8_STAGE(PG8_SB(0, 0), cB, voffB); PG8_STAGE(PG8_SA(0, 0), cA, voffA); PG8_STAGE(PG8_SB(0, 1), cB + hB, voffB); PG8_STAGE(PG8_SA(0, 1), cA + hA, voffA);
        if (wr == 1) PG8_BAR;
        PG8_WAIT_V(4); PG8_BAR;
        PG8_STAGE(PG8_SB(1, 0), cB + kstep, voffB); PG8_STAGE(PG8_SA(1, 0), cA + kstep, voffA); PG8_STAGE(PG8_SB(1, 1), cB + hB + kstep, voffB);
        PG8_WAIT_V(6); PG8_BAR;
    }
    for (;;) {
        const bool has_next = S.next(ui + 1, nxt);
        const char* nA = has_next ? (const char*)g.A + (size_t)nxt.br * g.astride + (size_t)nxt.pm * tA + (size_t)((nxt.pn >> 1) * g.akw) * 2 : cA; const char* nB = has_next ? (const char*)g.Bt + (size_t)(nxt.br * g.bpan + nxt.pn) * tB : cB;
        for (int t = 0; t < nt; t += 2) {
            const bool last = (t == nt - 2);
            const char* a1 = cA + (size_t)(t + 1) * kstep;
            const char* a2 = last ? nA : cA + (size_t)(t + 2) * kstep; const char* b2 = last ? nB : cB + (size_t)(t + 2) * kstep;
            const char* a3 = a2 + kstep; const char* b3 = b2 + kstep;
            if constexpr (SP2) {
            PG8_LDB(B0, 0, 0); PG8_LDB(B1, 0, 1); PG8_SCHED; PG8_LDA(At, 0, 0); PG8_STAGE(PG8_SA(1, 1), a1 + hA, voffA);
            PG8_WAIT_V(8); PG8_WAIT_L(0); PG8_BAR; PG8_MMA(0, 0, At, B0); PG8_MMA(0, 1, At, B1); PG8_BAR; PG8_SCHED;
            PG8_LDA(At, 0, 1); PG8_STAGE(PG8_SB(0, 0), b2, voffB); PG8_STAGE(PG8_SB(0, 1), b2 + hB, voffB); PG8_STAGE(PG8_SA(0, 0), a2, voffA);
            PG8_WAIT_V(8); PG8_WAIT_L(0); PG8_BAR; PG8_MMA(1, 0, At, B0); PG8_MMA(1, 1, At, B1); PG8_BAR; PG8_SCHED;
            PG8_LDB(B0, 1, 0); PG8_LDB(B1, 1, 1); PG8_SCHED; PG8_LDA(At, 1, 0); PG8_STAGE(PG8_SA(0, 1), a2 + hA, voffA);
            PG8_WAIT_V(8); PG8_WAIT_L(0); PG8_BAR; PG8_MMA(0, 0, At, B0); PG8_MMA(0, 1, At, B1); PG8_BAR; PG8_SCHED;
            PG8_LDA(At, 1, 1); PG8_STAGE(PG8_SB(1, 0), b3, voffB); PG8_STAGE(PG8_SB(1, 1), b3 + hB, voffB); PG8_STAGE(PG8_SA(1, 0), a3, voffA);
            PG8_WAIT_V(8); PG8_WAIT_L(0); PG8_BAR; PG8_MMA(1, 0, At, B0); PG8_MMA(1, 1, At, B1); PG8_BAR; PG8_SCHED;
            } else {
            PG8_LDB(B0, 0, 0); PG8_SCHED; PG8_LDA(At, 0, 0); PG8_STAGE(PG8_SA(1, 1), a1 + hA, voffA);
            PG8_WAIT_L(8); PG8_BAR; PG8_WAIT_L(0); PG8_MMA(0, 0, At, B0); PG8_BAR; PG8_SCHED;
            PG8_LDB(B1, 0, 1); PG8_STAGE(PG8_SB(0, 0), b2, voffB);
            PG8_BAR; PG8_WAIT_L(0); PG8_MMA(0, 1, At, B1); PG8_BAR;
            PG8_LDA(At, 0, 1); PG8_STAGE(PG8_SA(0, 0), a2, voffA);
            PG8_BAR; PG8_WAIT_L(0); PG8_MMA(1, 0, At, B0); PG8_BAR; PG8_SCHED;
            PG8_STAGE(PG8_SB(0, 1), b2 + hB, voffB);
            PG8_WAIT_V(6); PG8_BAR; PG8_MMA(1, 1, At, B1); PG8_BAR;
            PG8_LDB(B0, 1, 0); PG8_SCHED; PG8_LDA(At, 1, 0); PG8_STAGE(PG8_SA(0, 1), a2 + hA, voffA);
            PG8_WAIT_L(8); PG8_BAR; PG8_WAIT_L(0); PG8_MMA(0, 0, At, B0); PG8_BAR; PG8_SCHED;
            PG8_LDB(B1, 1, 1); PG8_STAGE(PG8_SB(1, 0), b3, voffB);
            PG8_BAR; PG8_WAIT_L(0); PG8_MMA(0, 1, At, B1); PG8_BAR;
            PG8_LDA(At, 1, 1); PG8_STAGE(PG8_SA(1, 0), a3, voffA);
            PG8_BAR; PG8_WAIT_L(0); PG8_MMA(1, 0, At, B0); PG8_BAR; PG8_SCHED;
            PG8_STAGE(PG8_SB(1, 1), b3 + hB, voffB);
            PG8_WAIT_V(6); PG8_BAR; PG8_MMA(1, 1, At, B1); PG8_BAR;
            }
        }
        if constexpr (ALIGN_EPI) { if (wr == 0) PG8_BAR; }
        if constexpr (Epi::KEEP) E.apply(acc, cur, wr, wc, fr, fq); else E(acc, cur, wr, wc, fr, fq);
        if (!has_next) break;
        if constexpr (Epi::INIT) E.init(acc, nxt, wr, wc, fr, fq);
        else if (!Epi::KEEP || nxt.br == 0) {
#pragma unroll
        for (int a = 0; a < 2; ++a)
#pragma unroll
            for (int b = 0; b < 2; ++b)
#pragma unroll
                for (int m = 0; m < 4; ++m)
#pragma unroll
                    for (int n = 0; n < 2; ++n) acc[a][b][m][n] = (f32x4){0.f, 0.f, 0.f, 0.f};
        }
        cur = nxt; cA = nA; cB = nB; ++ui;
        if constexpr (ALIGN_EPI) { if (wr == 1) PG8_BAR; }
    }
    PG8_WAIT_V(0);
    if constexpr (!ALIGN_EPI) { if (wr == 0) PG8_BAR; }
    PG8_BAR;
#undef PG8_SA
#undef PG8_SB
#undef PG8_STAGE
#undef PG8_LDA
#undef PG8_LDB
#undef PG8_MMA
#undef PG8_WAIT_V
#undef PG8_WAIT_L
#undef PG8_BAR
#undef PG8_SCHED
}
}
using pg8::Unit;

#define EPI_LOOP_AM _Pragma("unroll") for (int ai = 0; ai < 2; ++ai) _Pragma("unroll") for (int m = 0; m < 4; ++m)
__device__ __forceinline__ u32x4 pack8(const f32x4& a, const f32x4& b) { u32x4 o; o.x = cvt_pk_bf16(a[0], a[1]); o.y = cvt_pk_bf16(a[2], a[3]); o.z = cvt_pk_bf16(b[0], b[1]); o.w = cvt_pk_bf16(b[2], b[3]); return o; }
__device__ __forceinline__ void unpack8(const u32x4& v, float (&f)[8]) { f[0] = bflo(v.x); f[1] = bfhi(v.x); f[2] = bflo(v.y); f[3] = bfhi(v.y); f[4] = bflo(v.z); f[5] = bfhi(v.z); f[6] = bflo(v.w); f[7] = bfhi(v.w); }

struct EpiInProj {
    static constexpr bool PERM = true, INIT = false, KEEP = false;
    bf16_t* A5; bf16_t* ulru; bf16_t* qkv; bf16_t* gates; const float* bgate; const float* rstd;
    __device__ __forceinline__ void operator()(const f32x4 (&acc)[2][2][4][2], const Unit& u, int wr, int wc, int fr, int fq) const {
        const int row0 = u.pm * 256 + wr * 64 + fr, cl0 = wc * 32 + 8 * fq, pn = u.pn;
        if (pn < 4) {
            EPI_LOOP_AM { const int row = row0 + ai * 128 + m * 16, b = row >> 12, t = row & 4095, chunk = t >> 4, s = t & 15; const float rs = rstd[row];
#pragma unroll
                for (int bj = 0; bj < 2; ++bj) { const int ch = pn * 256 + bj * 128 + cl0, g = ch >> 4, c0 = ch & 15;
                    *(u32x4*)(A5 + ((size_t)((g * 4 + b) * 256 + chunk)) * 384 + s * 16 + c0) = pack8(acc[ai][bj][m][0] * rs, acc[ai][bj][m][1] * rs); } }
        } else if (pn < 8) {
            EPI_LOOP_AM { const int row = row0 + ai * 128 + m * 16; const float rs = rstd[row];
#pragma unroll
                for (int bj = 0; bj < 2; ++bj) *(u32x4*)(ulru + (size_t)row * 1024 + (pn - 4) * 256 + bj * 128 + cl0) = pack8(acc[ai][bj][m][0] * rs, acc[ai][bj][m][1] * rs); }
        } else if (pn < 20) {
            const int which = (pn - 8) >> 2, cb = ((pn - 8) & 3) * 256; bf16_t* base = qkv + (size_t)which * T_TOK * 1024;
            EPI_LOOP_AM { const int row = row0 + ai * 128 + m * 16; const float rs = rstd[row];
#pragma unroll
                for (int bj = 0; bj < 2; ++bj) *(u32x4*)(base + (size_t)row * 1024 + cb + bj * 128 + cl0) = pack8(acc[ai][bj][m][0] * rs, acc[ai][bj][m][1] * rs); }
        } else {
            const int gc0 = (pn - 20) * 256 + cl0;
            f32x4 bv[2][2];
#pragma unroll
            for (int bj = 0; bj < 2; ++bj)
#pragma unroll
                for (int n = 0; n < 2; ++n) bv[bj][n] = *(const f32x4*)(bgate + gc0 + bj * 128 + 4 * n);
            EPI_LOOP_AM { const int row = row0 + ai * 128 + m * 16; const float rs = rstd[row];
#pragma unroll
                for (int bj = 0; bj < 2; ++bj) { f32x4 v0 = acc[ai][bj][m][0] * rs + bv[bj][0], v1 = acc[ai][bj][m][1] * rs + bv[bj][1];
#pragma unroll
                    for (int j = 0; j < 4; ++j) { v0[j] = sigmoid_f(v0[j]); v1[j] = sigmoid_f(v1[j]); }
                    *(u32x4*)(gates + (size_t)row * 6144 + gc0 + bj * 128) = pack8(v0, v1); } }
        }
    }
};

struct EpiS5A {
    static constexpr bool PERM = false, INIT = false, KEEP = false;
    float* send;
    __device__ __forceinline__ void operator()(const f32x4 (&acc)[2][2][4][2], const Unit& u, int wr, int wc, int fr, int fq) const {
        const int row0 = u.pm * 256 + wr * 64 + fr, col0 = wc * 32 + 4 * fq;
        EPI_LOOP_AM { float* rp = send + (size_t)(row0 + ai * 128 + m * 16) * 128 + col0;
#pragma unroll
            for (int n = 0; n < 2; ++n) *(f32x4*)(rp + n * 16) = acc[ai][0][m][n]; }
    }
};

struct EpiS5B {
    static constexpr bool PERM = true, INIT = false, KEEP = false;
    const bf16_t* A5; const float* dsk; bf16_t* ypre;
    __device__ __forceinline__ void operator()(const f32x4 (&acc)[2][2][4][2], const Unit& u, int wr, int wc, int fr, int fq) const {
        const int g = u.pm >> 2, b = u.pm & 3, cl0 = wc * 32 + 8 * fq, c0 = (8 * fq) & 15;
        float dv[8];
#pragma unroll
        for (int e = 0; e < 8; ++e) dv[e] = dsk[g * 16 + c0 + e];
        const int chunk0 = wr * 64 + fr;
        const bf16_t* ub = A5 + ((size_t)u.pm * 256 + chunk0) * 384 + cl0;
        bf16_t* yb = ypre + ((size_t)(b * 4096 + chunk0 * 16 + (cl0 >> 4))) * 1024 + g * 16 + c0;
        EPI_LOOP_AM {
#pragma unroll
            for (int bj = 0; bj < 2; ++bj) {
                const u32x4 uu = *(const u32x4*)(ub + (size_t)(ai * 128 + m * 16) * 384 + bj * 128); float uf[8]; unpack8(uu, uf);
                f32x4 v0, v1;
#pragma unroll
                for (int j = 0; j < 4; ++j) { float y = acc[ai][bj][m][0][j] + dv[j] * uf[j]; float a = 0.7978845608028654f * (y + 0.044715f * y * y * y); v0[j] = y * sigmoid_f(2.f * a);
                    y = acc[ai][bj][m][1][j] + dv[4 + j] * uf[4 + j]; a = 0.7978845608028654f * (y + 0.044715f * y * y * y); v1[j] = y * sigmoid_f(2.f * a); }
                *(u32x4*)(yb + ((size_t)((ai * 128 + m * 16) * 16 + bj * 8)) * 1024) = pack8(v0, v1); } }
    }
};

struct EpiGlu {
    static constexpr bool PERM = true, INIT = false, KEEP = false;
    const bf16_t* ypre; const float* bglu; bf16_t* ys5;
    __device__ __forceinline__ void operator()(const f32x4 (&acc)[2][2][4][2], const Unit& u, int wr, int wc, int fr, int fq) const {
        const int row0 = u.pm * 256 + wr * 64 + fr, col0 = u.pn * 256 + wc * 32 + 8 * fq;
        f32x4 bv[2][2];
#pragma unroll
        for (int bj = 0; bj < 2; ++bj)
#pragma unroll
            for (int n = 0; n < 2; ++n) bv[bj][n] = *(const f32x4*)(bglu + col0 + bj * 128 + 4 * n);
        EPI_LOOP_AM { const size_t ro = (size_t)(row0 + ai * 128 + m * 16) * 1024 + col0;
#pragma unroll
            for (int bj = 0; bj < 2; ++bj) { const u32x4 yy = *(const u32x4*)(ypre + ro + bj * 128); float yf[8]; unpack8(yy, yf);
                f32x4 v0 = acc[ai][bj][m][0] + bv[bj][0], v1 = acc[ai][bj][m][1] + bv[bj][1];
#pragma unroll
                for (int j = 0; j < 4; ++j) { v0[j] = yf[j] * sigmoid_f(v0[j]); v1[j] = yf[4 + j] * sigmoid_f(v1[j]); }
                *(u32x4*)(ys5 + ro + bj * 128) = pack8(v0, v1); } }
    }
};

template <int D> __device__ __forceinline__ float dpp_row_shr(float idv, float v) {
    return __builtin_bit_cast(float, __builtin_amdgcn_update_dpp(__builtin_bit_cast(int, idv), __builtin_bit_cast(int, v), 0x110 + D, 0xf, 0xf, false)); }
#define LRU_SCAN_STEP(D) do { const float Ap = dpp_row_shr<D>(1.f, A), Hp = dpp_row_shr<D>(0.f, H); H = A * Hp + H; A = A * Ap; } while (0)
struct EpiLruGate {
    static constexpr bool PERM = true, INIT = false, KEEP = false;
    const bf16_t* xc; const float* br; const float* bi; const float* lam; float* EA; float* EH; float* sumA; float* sumH;
    __device__ __forceinline__ void operator()(const f32x4 (&acc)[2][2][4][2], const Unit& u, int wr, int wc, int fr, int fq) const {
        const int row0 = u.pm * 256 + wr * 64 + fr, ch0 = u.pn * 128 + wc * 32 + 8 * fq, lane = fr + 16 * fq, w = wr * 4 + wc;
        const int bb = u.pm >> 4, chunkb = (u.pm & 15) * 4 + wr;
        const size_t ebase = ((size_t)((u.pm * 8 + u.pn) * 8 + w)) * 2;
#pragma unroll
        for (int n = 0; n < 2; ++n) {
            float brv[4], biv[4], spl[4];
#pragma unroll
            for (int e = 0; e < 4; ++e) { brv[e] = br[ch0 + 4 * n + e]; biv[e] = bi[ch0 + 4 * n + e]; spl[e] = -8.f * log1pf(__expf(-lam[ch0 + 4 * n + e])); }
#pragma unroll
            for (int ai = 0; ai < 2; ++ai) {
                float cA[4] = {1.f, 1.f, 1.f, 1.f}, cH[4] = {0.f, 0.f, 0.f, 0.f};
#pragma unroll
                for (int m = 0; m < 4; ++m) {
                    const size_t ro = (size_t)(row0 + ai * 128 + m * 16) * 1024 + ch0 + 4 * n;
                    const u32x2 xx = *(const u32x2*)(xc + ro); const float xf[4] = {bflo(xx.x), bfhi(xx.x), bflo(xx.y), bfhi(xx.y)};
                    f32x4 av, hv;
#pragma unroll
                    for (int j = 0; j < 4; ++j) {
                        const float r = sigmoid_f(acc[ai][0][m][n][j] + brv[j]), ig = sigmoid_f(acc[ai][1][m][n][j] + biv[j]);
                        const float la = r * spl[j]; const float a = __expf(la); const float y2 = 2.f * la;
                        const float om = (y2 > -0.02f) ? -y2 * (1.f + y2 * (0.5f + y2 * (1.f / 6.f))) : (1.f - a * a);
                        float A = a, H = __builtin_amdgcn_sqrtf(om) * (ig * xf[j]);
                        LRU_SCAN_STEP(1); LRU_SCAN_STEP(2); LRU_SCAN_STEP(4); LRU_SCAN_STEP(8);
                        H = A * cH[j] + H; A = A * cA[j];
                        av[j] = A; hv[j] = H;
                        cA[j] = __shfl(A, (lane & 48) + 15); cH[j] = __shfl(H, (lane & 48) + 15); }
                    const size_t eo = ((((ebase + ai) * 4 + m) * 2 + n) * 64 + lane) * 4;
                    *(f32x4*)(EA + eo) = av; *(f32x4*)(EH + eo) = hv; }
                if (fr == 15) { const size_t so = ((size_t)(bb * 64 + chunkb + 2 * ai)) * 1024 + ch0 + 4 * n;
                    *(f32x4*)(sumA + so) = (f32x4){cA[0], cA[1], cA[2], cA[3]}; *(f32x4*)(sumH + so) = (f32x4){cH[0], cH[1], cH[2], cH[3]}; } } }
    }
};

struct EpiMerge {
    static constexpr bool PERM = true, INIT = false, KEEP = true;
    const bf16_t* gates; bf16_t* merged;
    __device__ __forceinline__ void apply(f32x4 (&acc)[2][2][4][2], const Unit& u, int wr, int wc, int fr, int fq) const {
        const int row0 = u.pm * 256 + wr * 64 + fr, col0 = u.pn * 256 + wc * 32 + 8 * fq, br = u.br;
        EPI_LOOP_AM { const int row = row0 + ai * 128 + m * 16;
#pragma unroll
            for (int bj = 0; bj < 2; ++bj) { const bf16_t* gp = gates + (size_t)row * 6144 + col0 + bj * 128;
                float sc[8];
                if (br < 2) { const u32x4 ga = *(const u32x4*)(gp + br * 2048), gb = *(const u32x4*)(gp + (br + 1) * 2048); float fa[8], fb[8]; unpack8(ga, fa); unpack8(gb, fb);
#pragma unroll
                    for (int e = 0; e < 8; ++e) sc[e] = fmaxf(fa[e], 1e-20f) * __builtin_amdgcn_rcpf(fmaxf(fb[e], 1e-20f));
                } else { const u32x4 ga = *(const u32x4*)(gp + 2 * 2048); float fa[8]; unpack8(ga, fa);
#pragma unroll
                    for (int e = 0; e < 8; ++e) sc[e] = fmaxf(fa[e], 1e-20f); }
#pragma unroll
                for (int j = 0; j < 4; ++j) { acc[ai][bj][m][0][j] *= sc[j]; acc[ai][bj][m][1][j] *= sc[4 + j]; }
                if (br == 2) *(u32x4*)(merged + (size_t)row * 2048 + col0 + bj * 128) = pack8(acc[ai][bj][m][0], acc[ai][bj][m][1]); } }
    }
    __device__ __forceinline__ void operator()(const f32x4 (&)[2][2][4][2], const Unit&, int, int, int, int) const {}
};

struct EpiResid {
    static constexpr bool PERM = true, INIT = true, KEEP = false;
    const float* rin; float* out; bf16_t* hb; float* part;
    __device__ __forceinline__ void init(f32x4 (&acc)[2][2][4][2], const Unit& u, int wr, int wc, int fr, int fq) const {
        const int row0 = u.pm * 256 + wr * 64 + fr, col0 = u.pn * 256 + wc * 32 + 8 * fq;
        EPI_LOOP_AM { const size_t ro = (size_t)(row0 + ai * 128 + m * 16) * 2048 + col0;
#pragma unroll
            for (int bj = 0; bj < 2; ++bj)
#pragma unroll
                for (int n = 0; n < 2; ++n) acc[ai][bj][m][n] = *(const f32x4*)(rin + ro + bj * 128 + n * 4); }
    }
    __device__ __forceinline__ void operator()(const f32x4 (&acc)[2][2][4][2], const Unit& u, int wr, int wc, int fr, int fq) const {
        const int row0 = u.pm * 256 + wr * 64 + fr, col0 = u.pn * 256 + wc * 32 + 8 * fq;
        EPI_LOOP_AM { const int row = row0 + ai * 128 + m * 16; const size_t ro = (size_t)row * 2048 + col0; float ss = 0.f;
#pragma unroll
            for (int bj = 0; bj < 2; ++bj) { const f32x4 v0 = acc[ai][bj][m][0], v1 = acc[ai][bj][m][1];
                *(f32x4*)(out + ro + bj * 128) = v0; *(f32x4*)(out + ro + bj * 128 + 4) = v1;
                *(u32x4*)(hb + ro + bj * 128) = pack8(v0, v1);
                ss += ((v0[0] * v0[0] + v0[1] * v0[1]) + (v0[2] * v0[2] + v0[3] * v0[3])) + ((v1[0] * v1[0] + v1[1] * v1[1]) + (v1[2] * v1[2] + v1[3] * v1[3])); }
            ss += __shfl_xor(ss, 16); ss += __shfl_xor(ss, 32);
            if (fq == 0) part[(size_t)row * 32 + u.pn * 4 + wc] = ss; }
    }
};

struct EpiUp {
    static constexpr bool PERM = true, INIT = false, KEEP = false;
    bf16_t* hdn; const float* rstd;
    __device__ __forceinline__ void operator()(const f32x4 (&acc)[2][2][4][2], const Unit& u, int wr, int wc, int fr, int fq) const {
        const int row0 = u.pm * 256 + wr * 64 + fr, col0 = u.pn * 256 + wc * 32 + 8 * fq;
        EPI_LOOP_AM { const int row = row0 + ai * 128 + m * 16; const size_t ro = (size_t)row * 8192 + col0; const float rs = rstd[row];
#pragma unroll
            for (int bj = 0; bj < 2; ++bj) { f32x4 v0 = acc[ai][bj][m][0], v1 = acc[ai][bj][m][1];
#pragma unroll
                for (int j = 0; j < 4; ++j) { const float a = fmaxf(v0[j] * rs, 0.f), b = fmaxf(v1[j] * rs, 0.f); v0[j] = a * a; v1[j] = b * b; }
                *(u32x4*)(hdn + ro + bj * 128) = pack8(v0, v1); } }
    }
};

__device__ __forceinline__ void transpose_item(const float* W, const float* kscale, int K, int N, bf16_t* WT, LAS float* scr, int item, int lane) {
    const int nblk = N / 64, kb = item / nblk, nb = item % nblk, k0 = 64 * kb, n0 = 64 * nb;
    const int n4 = lane & 15, ks = lane >> 4;
    f32x4 v[16];
#pragma unroll
    for (int i = 0; i < 16; ++i) { v[i] = __builtin_nontemporal_load((const f32x4*)(W + (size_t)(k0 + 4 * i + ks) * N + n0 + 4 * n4)); if (kscale) v[i] = v[i] * kscale[k0 + 4 * i + ks]; }
#pragma unroll
    for (int i = 0; i < 16; ++i) { LAS float* d = scr + (4 * i + ks) * 65 + 4 * n4; d[0] = v[i][0]; d[1] = v[i][1]; d[2] = v[i][2]; d[3] = v[i][3]; }
    asm volatile("s_waitcnt lgkmcnt(0)" ::: "memory"); __builtin_amdgcn_wave_barrier();
    const int c = lane & 7;
#pragma unroll
    for (int j = 0; j < 8; ++j) { const int n = (lane >> 3) + 8 * j; const LAS float* sp = scr + (8 * c) * 65 + n;
        u32x4 o; o.x = cvt_pk_bf16(sp[0 * 65], sp[1 * 65]); o.y = cvt_pk_bf16(sp[2 * 65], sp[3 * 65]); o.z = cvt_pk_bf16(sp[4 * 65], sp[5 * 65]); o.w = cvt_pk_bf16(sp[6 * 65], sp[7 * 65]);
        *(u32x4*)(WT + (size_t)(n0 + n) * K + k0 + 8 * c) = o; }
    asm volatile("s_waitcnt lgkmcnt(0)" ::: "memory"); __builtin_amdgcn_wave_barrier();
}
__device__ __forceinline__ void transpose_matrix(const float* W, int K, int N, bf16_t* WT, LAS float* scr, int gw, int NGW, int lane, const float* kscale = nullptr) {
    const int nitems = (K / 64) * (N / 64);
    for (int it = gw; it < nitems; it += NGW) transpose_item(W, kscale, K, N, WT, scr, it, lane);
}

template <bool F32OUT>
__device__ __forceinline__ void rmsnorm_rows(const float* src, const float* g, void* dst, int gw, int NGW, int lane) {
    for (int row = gw; row < T_TOK; row += NGW) {
        const f32x4* xr = (const f32x4*)(src + (size_t)row * 2048) + lane;
        f32x4 v[8]; float ss = 0.f;
#pragma unroll
        for (int j = 0; j < 8; ++j) { v[j] = xr[64 * j]; ss += (v[j][0] * v[j][0] + v[j][1] * v[j][1]) + (v[j][2] * v[j][2] + v[j][3] * v[j][3]); }
        const float rstd = 1.f / sqrtf(wave_sum(ss) * (1.f / 2048.f) + EPSN);
#pragma unroll
        for (int j = 0; j < 8; ++j) { const f32x4 gg = *((const f32x4*)g + lane + 64 * j); f32x4 o;
#pragma unroll
            for (int e = 0; e < 4; ++e) o[e] = v[j][e] * rstd * gg[e];
            if (F32OUT) *((f32x4*)((float*)dst + (size_t)row * 2048) + lane + 64 * j) = o;
            else { u32x2 p; p.x = cvt_pk_bf16(o[0], o[1]); p.y = cvt_pk_bf16(o[2], o[3]); *((u32x2*)((bf16_t*)dst + (size_t)row * 2048) + lane + 64 * j) = p; } }
    }
}

__device__ __forceinline__ void x_prep_rows(const float* src, bf16_t* hb, float* rstd, int gw, int NGW, int lane) {
    for (int row = gw; row < T_TOK; row += NGW) {
        const f32x4* xr = (const f32x4*)(src + (size_t)row * 2048) + lane;
        f32x4 v[8]; float ss = 0.f;
#pragma unroll
        for (int j = 0; j < 8; ++j) { v[j] = xr[64 * j]; ss += (v[j][0] * v[j][0] + v[j][1] * v[j][1]) + (v[j][2] * v[j][2] + v[j][3] * v[j][3]); }
        ss = wave_sum(ss);
        if (lane == 0) rstd[row] = 1.f / sqrtf(ss * (1.f / 2048.f) + EPSN);
#pragma unroll
        for (int j = 0; j < 8; ++j) { u32x2 p; p.x = cvt_pk_bf16(v[j][0], v[j][1]); p.y = cvt_pk_bf16(v[j][2], v[j][3]); *((u32x2*)(hb + (size_t)row * 2048) + lane + 64 * j) = p; }
    }
}
__device__ __forceinline__ void rstd_rows(const float* part, float* rstd, int gt, int NGT) {
    for (int row = gt; row < T_TOK; row += NGT) { const f32x4* p = (const f32x4*)(part + (size_t)row * 32); float ss = 0.f;
#pragma unroll
        for (int j = 0; j < 8; ++j) { const f32x4 q = p[j]; ss += (q[0] + q[1]) + (q[2] + q[3]); }
        rstd[row] = 1.f / sqrtf(ss * (1.f / 2048.f) + EPSN); }
}

__device__ __forceinline__ void s5_prep_item(int g, int q, const float* lam_re, const float* lam_im, const float* log_dt, const float* b_re, const float* b_im,
                                             const float* c_re, const float* c_im, float* ptab, float* ktau, bf16_t* M2, LAS float* sm, int tid) {
    LAS float* Pr = sm;
    LAS float* Pi = sm + 1088;
    LAS float* Br = sm + 2176;
    LAS float* Bi = sm + 3200;
    LAS float* Cr = sm + 4224;
    LAS float* Ci = sm + 5264;
    const double dt = (double)expf(log_dt[g]);
    for (int idx = tid; idx < 1088; idx += 512) { const int p = idx / 17, tau = idx % 17;
        const double lr = lam_re[g * 64 + p], li = lam_im[g * 64 + p];
        const float mag = expf((float)(lr * dt * tau)); double ang = li * dt * tau; ang -= 6.283185307179586 * rint(ang * 0.15915494309189535);
        const float fa = (float)ang; Pr[idx] = mag * cosf(fa); Pi[idx] = mag * sinf(fa); }
    for (int idx = tid; idx < 1024; idx += 512) { const int c = idx >> 6, p = idx & 63; Cr[c * 65 + p] = c_re[(g * 16 + c) * 64 + p]; Ci[c * 65 + p] = c_im[(g * 16 + c) * 64 + p]; }
    __syncthreads();
    for (int idx = tid; idx < 1024; idx += 512) { const int p = idx >> 4;
        const float lr = lam_re[g * 64 + p], li = lam_im[g * 64 + p];
        const float xr = Pr[p * 17 + 1] - 1.f, xi = Pi[p * 17 + 1]; const float den = 1.f / (lr * lr + li * li);
        const float fr_ = (xr * lr + xi * li) * den, fi_ = (xi * lr - xr * li) * den;
        const float br_ = b_re[(size_t)g * 1024 + idx], bi_ = b_im[(size_t)g * 1024 + idx];
        Br[idx] = fr_ * br_ - fi_ * bi_; Bi[idx] = fr_ * bi_ + fi_ * br_; }
    __syncthreads();
    if (q == 0) for (int idx = tid; idx < 1088; idx += 512) { ptab[((size_t)g * 1088 + idx) * 2] = Pr[idx]; ptab[((size_t)g * 1088 + idx) * 2 + 1] = Pi[idx]; }
    { const int nl = tid >> 3, n = 64 * q + nl, kb = (tid & 7) * 32; bf16_t* dst = M2 + ((size_t)(g * 256 + n)) * 256 + kb;
#pragma unroll
        for (int v = 0; v < 4; ++v) { float f[8];
#pragma unroll
            for (int e = 0; e < 8; ++e) { const int k = kb + v * 8 + e, s = k >> 4, c = k & 15; float val = 0.f;
                if (q < 2) { const int p = nl; const float pr = Pr[p * 17 + 15 - s], pi = Pi[p * 17 + 15 - s], b0 = Br[p * 16 + c], b1 = Bi[p * 16 + c];
                    val = (q == 0) ? (pr * b0 - pi * b1) : (pr * b1 + pi * b0); }
                f[e] = val; }
            u32x4 o; o.x = cvt_pk_bf16(f[0], f[1]); o.y = cvt_pk_bf16(f[2], f[3]); o.z = cvt_pk_bf16(f[4], f[5]); o.w = cvt_pk_bf16(f[6], f[7]);
            *(u32x4*)(dst + v * 8) = o; } }
#pragma unroll
    for (int r = 0; r < 2; ++r) { const int o = tid + 512 * r, tau = 4 * q + (o >> 8), cp = (o >> 4) & 15, c = o & 15; float sum = 0.f;
        for (int p = 0; p < 64; ++p) { const float cr = Cr[cp * 65 + p], ci = Ci[cp * 65 + p], pr = Pr[p * 17 + tau], pi = Pi[p * 17 + tau];
            const float gr = cr * pr - ci * pi, gi = cr * pi + ci * pr; sum += gr * Br[p * 16 + c] - gi * Bi[p * 16 + c]; }
        ktau[(size_t)g * 4096 + tau * 256 + cp * 16 + c] = sum; }
    __syncthreads();
}

__device__ __forceinline__ void s5_fill_m13(const float* ktau, const float* ptab, const float* c_re, const float* c_im, bf16_t* M13, int gt, int NGT) {
    for (int it = gt; it < 64 * 256 * 48; it += NGT) { const int k8 = it % 48, n = (it / 48) & 255, g = it / (48 * 256); const int t = n >> 4, cp = n & 15; float f[8];
        if (k8 < 32) { const int s = k8 >> 1, c0 = (k8 & 1) * 8;
            if (s <= t) { const float* kp = ktau + (size_t)g * 4096 + (t - s) * 256 + cp * 16 + c0;
#pragma unroll
                for (int e = 0; e < 8; ++e) f[e] = kp[e]; }
            else {
#pragma unroll
                for (int e = 0; e < 8; ++e) f[e] = 0.f; }
        } else { const int kk = (k8 - 32) * 8, im = kk >> 6, p0 = kk & 63;
#pragma unroll
            for (int e = 0; e < 8; ++e) { const int p = p0 + e; const float cr = c_re[(g * 16 + cp) * 64 + p], ci = c_im[(g * 16 + cp) * 64 + p];
                const float pr = ptab[((size_t)g * 1088 + p * 17 + t + 1) * 2], pi = ptab[((size_t)g * 1088 + p * 17 + t + 1) * 2 + 1];
                f[e] = im ? -(cr * pi + ci * pr) : (cr * pr - ci * pi); } }
        u32x4 o; o.x = cvt_pk_bf16(f[0], f[1]); o.y = cvt_pk_bf16(f[2], f[3]); o.z = cvt_pk_bf16(f[4], f[5]); o.w = cvt_pk_bf16(f[6], f[7]);
        *(u32x4*)(M13 + ((size_t)(g * 256 + n)) * 384 + k8 * 8) = o; }
}

__device__ __forceinline__ void lru_fill_w(const float* w_r, const float* w_i, bf16_t* WL, int gt, int NGT) {
    for (int it = gt; it < 2048 * 32; it += NGT) { const int k8 = it & 31, row = it >> 5; const int pn = row >> 8, which = (row >> 7) & 1, j = row & 127;
        const int ch = pn * 128 + j, nblk = ch >> 6, kk = ch & 63, kin0 = (pn >> 1) * 256 + k8 * 8; float f[8];
        if ((kin0 >> 6) == nblk) { const float* w = (which ? w_i : w_r) + ((size_t)(nblk * 64 + (kin0 & 63))) * 64 + kk;
#pragma unroll
            for (int e = 0; e < 8; ++e) f[e] = w[e * 64]; }
        else {
#pragma unroll
            for (int e = 0; e < 8; ++e) f[e] = 0.f; }
        u32x4 o; o.x = cvt_pk_bf16(f[0], f[1]); o.y = cvt_pk_bf16(f[2], f[3]); o.z = cvt_pk_bf16(f[4], f[5]); o.w = cvt_pk_bf16(f[6], f[7]);
        *(u32x4*)(WL + (size_t)row * 256 + k8 * 8) = o; }
}

__device__ __forceinline__ void lru_conv(const bf16_t* ulru, const float* cw, const float* cb, bf16_t* xc, int gt, int NGT) {
    for (int it = gt; it < (T_TOK / 16) * 128; it += NGT) { const int c8 = it & 127, seg = it >> 7, tok0 = seg * 16, ch = c8 * 8;
        float w[4][8], bs[8];
#pragma unroll
        for (int e = 0; e < 8; ++e) bs[e] = cb[ch + e];
#pragma unroll
        for (int k = 0; k < 4; ++k)
#pragma unroll
            for (int e = 0; e < 8; ++e) w[k][e] = cw[k * 1024 + ch + e];
        float x0[8], x1[8], x2[8];
        const bool head = (tok0 & 4095) == 0;
        { u32x4 z = {0u, 0u, 0u, 0u};
          const u32x4 a0 = head ? z : *(const u32x4*)(ulru + (size_t)(tok0 - 3) * 1024 + ch), a1 = head ? z : *(const u32x4*)(ulru + (size_t)(tok0 - 2) * 1024 + ch), a2 = head ? z : *(const u32x4*)(ulru + (size_t)(tok0 - 1) * 1024 + ch);
          unpack8(a0, x0); unpack8(a1, x1); unpack8(a2, x2); }
        u32x4 cur[16];
#pragma unroll
        for (int t = 0; t < 16; ++t) cur[t] = *(const u32x4*)(ulru + (size_t)(tok0 + t) * 1024 + ch);
#pragma unroll
        for (int t = 0; t < 16; ++t) { float x3[8]; unpack8(cur[t], x3); float a[8];
#pragma unroll
            for (int e = 0; e < 8; ++e) a[e] = bs[e] + w[0][e] * x0[e] + w[1][e] * x1[e] + w[2][e] * x2[e] + w[3][e] * x3[e];
            u32x4 o; o.x = cvt_pk_bf16(a[0], a[1]); o.y = cvt_pk_bf16(a[2], a[3]); o.z = cvt_pk_bf16(a[4], a[5]); o.w = cvt_pk_bf16(a[6], a[7]);
            *(u32x4*)(xc + (size_t)(tok0 + t) * 1024 + ch) = o;
#pragma unroll
            for (int e = 0; e < 8; ++e) { x0[e] = x1[e]; x1[e] = x2[e]; x2[e] = x3[e]; } }
    }
}

__device__ __forceinline__ void s5_panel_scan(const float* send, const float* ptab, bf16_t* A5, LAS unsigned char* lds, int bid, int G, int tid) {
    const int lane = tid & 63, wave = __builtin_amdgcn_readfirstlane(tid >> 6);
    LAS float* S = (LAS float*)lds;
    LAS float* E = (LAS float*)(lds + 131072);
    for (int pm = bid; pm < 256; pm += G) { const int g = pm >> 2;
        const f32x4* src = (const f32x4*)(send + (size_t)pm * 256 * 128);
#pragma unroll
        for (int i = 0; i < 16; ++i) { const int idx = i * 512 + tid; *(LAS f32x4*)(S + idx * 4) = src[idx]; }
        const float lr = ptab[((size_t)g * 1088 + lane * 17 + 16) * 2], li = ptab[((size_t)g * 1088 + lane * 17 + 16) * 2 + 1];
        __syncthreads();
        float hr = 0.f, hi = 0.f;
        for (int j = 0; j < 32; ++j) { const int c = wave * 32 + j; const float sr = S[c * 128 + lane], si = S[c * 128 + 64 + lane];
            S[c * 128 + lane] = hr; S[c * 128 + 64 + lane] = hi;
            const float nr = lr * hr - li * hi + sr, ni = lr * hi + li * hr + si; hr = nr; hi = ni; }
        E[wave * 128 + lane] = hr; E[wave * 128 + 64 + lane] = hi;
        __syncthreads();
        float pr = lr, pi = li;
#pragma unroll
        for (int k = 0; k < 5; ++k) { const float t0 = pr * pr - pi * pi, t1 = 2.f * pr * pi; pr = t0; pi = t1; }
        float cr = 0.f, ci = 0.f;
        for (int v = 0; v < wave; ++v) { const float er = E[v * 128 + lane], ei = E[v * 128 + 64 + lane]; const float nr = pr * cr - pi * ci + er, ni = pr * ci + pi * cr + ei; cr = nr; ci = ni; }
        float wr_ = 1.f, wi_ = 0.f;
        for (int j = 0; j < 32; ++j) { const int c = wave * 32 + j;
            const float sr = S[c * 128 + lane] + (wr_ * cr - wi_ * ci), si = S[c * 128 + 64 + lane] + (wr_ * ci + wi_ * cr);
            const size_t R = (size_t)pm * 256 + c; A5[R * 384 + 256 + lane] = f2bf(sr); A5[R * 384 + 320 + lane] = f2bf(si);
            const float nr = lr * wr_ - li * wi_, ni = lr * wi_ + li * wr_; wr_ = nr; wi_ = ni; }
        __syncthreads();
    }
}

__device__ __forceinline__ void lru_fixup(const float* EA, const float* EH, const float* sumA, const float* sumH, bf16_t* ylru, int gw, int NGW, int lane) {
    const int fr = lane & 15, fq = lane >> 4;
    for (int id = gw; id < 8192; id += NGW) { const int ai = id & 1, w = (id >> 1) & 7, pn = (id >> 4) & 7, pm = id >> 7, wr = w >> 2, wc = w & 3;
        const int ch0 = pn * 128 + wc * 32 + 8 * fq, bb = pm >> 4, chunk = (pm & 15) * 4 + 2 * ai + wr;
        const f32x4* ea = (const f32x4*)EA + (size_t)id * 512 + lane; const f32x4* eh = (const f32x4*)EH + (size_t)id * 512 + lane;
        f32x4 va[8], vh[8];
#pragma unroll
        for (int q = 0; q < 8; ++q) { va[q] = ea[q * 64]; vh[q] = eh[q * 64]; }
        f32x4 cc[2];
#pragma unroll
        for (int n = 0; n < 2; ++n) { f32x4 sa[4], sh[4];
#pragma unroll
            for (int i = 0; i < 4; ++i) { const size_t o = (size_t)(bb * 64 + 4 * fr + i) * 1024 + ch0 + 4 * n; sa[i] = *(const f32x4*)(sumA + o); sh[i] = *(const f32x4*)(sumH + o); }
#pragma unroll
            for (int j = 0; j < 4; ++j) { float A = 1.f, H = 0.f;
#pragma unroll
                for (int i = 0; i < 4; ++i) { const bool ok = (4 * fr + i) < chunk; const float a = ok ? sa[i][j] : 1.f, g = ok ? sh[i][j] : 0.f; H = a * H + g; A = a * A; }
                LRU_SCAN_STEP(1); LRU_SCAN_STEP(2); LRU_SCAN_STEP(4); LRU_SCAN_STEP(8);
                cc[n][j] = __shfl(H, (lane & 48) + 15); } }
#pragma unroll
        for (int m = 0; m < 4; ++m) { const f32x4 h0 = vh[2 * m] + va[2 * m] * cc[0], h1 = vh[2 * m + 1] + va[2 * m + 1] * cc[1];
            *(u32x4*)(ylru + (size_t)(pm * 256 + ai * 128 + wr * 64 + m * 16 + fr) * 1024 + ch0) = pack8(h0, h1); }
    }
}

#define MFMA32(a, b, c) __builtin_amdgcn_mfma_f32_32x32x16_bf16((a), (b), (c), 0, 0, 0)
__device__ __forceinline__ void attn_task(const bf16_t* Q, const bf16_t* K, const bf16_t* V, bf16_t* O, int b, int h, int qt, LAS unsigned char* vlds, int lane) {
    const int l32 = lane & 31, hh = lane >> 5;
    const size_t base = (size_t)b * 4096;
    const int q0 = qt * 32, colh = h * 128, qidx = q0 + l32;
    bf16x8 qf[8];
    { const bf16_t* qp = Q + (base + q0 + l32) * 1024 + colh + 8 * hh;
#pragma unroll
        for (int kk = 0; kk < 8; ++kk) qf[kk] = *(const bf16x8*)(qp + 16 * kk); }
    f32x16 o[4];
#pragma unroll
    for (int d = 0; d < 4; ++d)
#pragma unroll
        for (int r = 0; r < 16; ++r) o[d][r] = 0.f;
    float R = 0.f;
    bf16x8 kf[8];
    { const bf16_t* kp = K + (base + q0 + l32) * 1024 + colh + 8 * hh;
#pragma unroll
        for (int kk = 0; kk < 8; ++kk) kf[kk] = *(const bf16x8*)(kp + 16 * kk); }
    int vb = 0;
#pragma unroll
    for (int i = 0; i < 8; ++i) { const int idx = i * 64 + lane, row = idx >> 4, ck = idx & 15;
        const u32x4 vv = *(const u32x4*)(V + (base + q0 + row) * 1024 + colh + ck * 8);
        *(LAS u32x4*)(vlds + row * 256 + ck * 16) = vv; }
    for (int kt = qt; kt >= 0; --kt) {
        const int k0 = kt * 32;
        u32x4 vn[8];
        if (kt > 0) {
#pragma unroll
            for (int i = 0; i < 8; ++i) { const int idx = i * 64 + lane, row = idx >> 4, ck = idx & 15; vn[i] = *(const u32x4*)(V + (base + k0 - 32 + row) * 1024 + colh + ck * 8); } }
        f32x16 S;
#pragma unroll
        for (int r = 0; r < 16; ++r) S[r] = 0.f;
#pragma unroll
        for (int kk = 0; kk < 8; ++kk) S = MFMA32(kf[kk], qf[kk], S);
        if (kt > 0) { const bf16_t* kp = K + (base + k0 - 32 + l32) * 1024 + colh + 8 * hh;
#pragma unroll
            for (int kk = 0; kk < 8; ++kk) kf[kk] = *(const bf16x8*)(kp + 16 * kk); }
        const bool diag = (kt == qt);
        float lk[16], ls[16];
#pragma unroll
        for (int r = 0; r < 16; ++r) { const float z = S[r] * 0.08838834764831845f; const float sp = fmaxf(z, 0.f) + __logf(1.f + __expf(-fabsf(z)));
            const int kidx = k0 + (r & 3) + 8 * (r >> 2) + 4 * hh; const bool valid = (!diag) || (kidx < qidx);
            lk[r] = valid ? -sp : 0.f; ls[r] = valid ? (z - sp) : -1e30f; }
        float gs[4], og[4], tail[4];
#pragma unroll
        for (int g = 0; g < 4; ++g) { gs[g] = (lk[4 * g] + lk[4 * g + 1]) + (lk[4 * g + 2] + lk[4 * g + 3]); og[g] = __shfl_xor(gs[g], 32); }
        float accs = 0.f;
#pragma unroll
        for (int g = 3; g >= 0; --g) { tail[g] = accs + (hh == 0 ? og[g] : 0.f); accs += gs[g] + og[g]; }
        float w[16];
#pragma unroll
        for (int g = 0; g < 4; ++g) { const float bs = R + tail[g]; const float i2 = lk[4 * g + 3], i1 = i2 + lk[4 * g + 2], i0 = i1 + lk[4 * g + 1];
            w[4 * g + 3] = __expf(ls[4 * g + 3] + bs); w[4 * g + 2] = __expf(ls[4 * g + 2] + bs + i2);
            w[4 * g + 1] = __expf(ls[4 * g + 1] + bs + i1); w[4 * g] = __expf(ls[4 * g] + bs + i0); }
        R += accs;
        bf16x8 wf[2];
#pragma unroll
        for (int s = 0; s < 2; ++s) { u32x4 p; p.x = cvt_pk_bf16(w[8 * s], w[8 * s + 1]); p.y = cvt_pk_bf16(w[8 * s + 2], w[8 * s + 3]); p.z = cvt_pk_bf16(w[8 * s + 4], w[8 * s + 5]); p.w = cvt_pk_bf16(w[8 * s + 6], w[8 * s + 7]);
            wf[s] = __builtin_bit_cast(bf16x8, p); }
        asm volatile("s_waitcnt lgkmcnt(0)" ::: "memory"); __builtin_amdgcn_wave_barrier();
#pragma unroll
        for (int db = 0; db < 4; ++db)
#pragma unroll
            for (int s = 0; s < 2; ++s) { bf16x8 vf;
#pragma unroll
                for (int j = 0; j < 8; ++j) { const int row = 16 * s + 8 * (j >> 2) + 4 * hh + (j & 3); vf[j] = *(const LAS short*)(vlds + vb * 8192 + row * 256 + (32 * db + l32) * 2); }
                o[db] = MFMA32(vf, wf[s], o[db]); }
        asm volatile("s_waitcnt lgkmcnt(0)" ::: "memory"); __builtin_amdgcn_wave_barrier();
        if (__ballot(R > -120.f) == 0ull) break;
        if (kt > 0) {
#pragma unroll
            for (int i = 0; i < 8; ++i) { const int idx = i * 64 + lane, row = idx >> 4, ck = idx & 15; *(LAS u32x4*)(vlds + (vb ^ 1) * 8192 + row * 256 + ck * 16) = vn[i]; } }
        vb ^= 1;
    }
    bf16_t* op = O + (base + q0 + l32) * 1024 + colh + 4 * hh;
#pragma unroll
    for (int db = 0; db < 4; ++db)
#pragma unroll
        for (int g4 = 0; g4 < 4; ++g4) { u32x2 p; p.x = cvt_pk_bf16(o[db][4 * g4], o[db][4 * g4 + 1]); p.y = cvt_pk_bf16(o[db][4 * g4 + 2], o[db][4 * g4 + 3]);
            *(u32x2*)(op + 32 * db + 8 * g4) = p; }
}

#define XB_TMO      128
#define XB_XCNT(j)  (256  + 64 * (j))
#define XB_XSUB(j)  (1280 + 64 * (j))
#define XB_XGEN(j)  (2304 + 64 * (j))
#define XB_TOP      3328
#define XB_TOPGEN   3392
#define XCD_BAR_WORDS 3456
#define XB_SPIN_CAP (1u << 20)
__device__ __forceinline__ unsigned xb_ld(unsigned* p)              { return __hip_atomic_load(p, __ATOMIC_RELAXED, __HIP_MEMORY_SCOPE_AGENT); }
__device__ __forceinline__ unsigned xb_add(unsigned* p, unsigned v) { return __hip_atomic_fetch_add(p, v, __ATOMIC_RELAXED, __HIP_MEMORY_SCOPE_AGENT); }
__device__ __forceinline__ unsigned xb_xcc_id() { return (unsigned)__builtin_amdgcn_s_getreg((3 << 11) | 20) & 0xFu; }
#define XB_SPIN(cond, bar) do { unsigned _sp = 0; while (cond) { __builtin_amdgcn_s_sleep(1); \
    if ((++_sp & 255u) == 0u) { if (xb_ld(&(bar)[XB_TMO])) break; if (_sp > XB_SPIN_CAP) { atomicAdd(&(bar)[XB_TMO], 1u); break; } } } } while (0)
struct XcdBarrier { unsigned* bar; unsigned x; volatile LAS unsigned* st; };
__device__ __forceinline__ XcdBarrier xcd_barrier_post(unsigned* bar, volatile LAS unsigned* st) {
    XcdBarrier b; b.bar = bar; b.x = xb_xcc_id(); b.st = st;
    if (threadIdx.x == 0) (void)xb_add(&bar[XB_XCNT(b.x)], 1u);
    return b;
}
__device__ __forceinline__ void xcd_barrier_complete(unsigned* bar, unsigned x, unsigned& nloc, unsigned& nx) {
    const unsigned G = gridDim.x * gridDim.y * gridDim.z;
    unsigned sum, cnt, mine, sp = 0u;
    for (;;) {
        sum = 0u; cnt = 0u; mine = 0u;
#pragma unroll
        for (unsigned j = 0; j < 16; ++j) { const unsigned c = xb_ld(&bar[XB_XCNT(j)]); sum += c; cnt += (c > 0u) ? 1u : 0u; mine = (j == x) ? c : mine; }
        if (sum == G) break;
        __builtin_amdgcn_s_sleep(1);
        if ((++sp & 255u) == 0u) { if (xb_ld(&bar[XB_TMO])) break; if (sp > XB_SPIN_CAP) { atomicAdd(&bar[XB_TMO], 1u); break; } }
    }
    nloc = mine > 0u ? mine : 1u; nx = cnt > 0u ? cnt : 1u;
}
__device__ __forceinline__ void xcd_barrier(const XcdBarrier& b) {
    asm volatile("s_waitcnt vmcnt(0)" ::: "memory");
    __syncthreads();
    if (threadIdx.x == 0) {
        unsigned* bar = b.bar;
        __builtin_amdgcn_s_waitcnt(0);
        unsigned nloc = b.st[0], nx = b.st[1];
        if (nloc == 0u) { xcd_barrier_complete(bar, b.x, nloc, nx); b.st[0] = nloc; b.st[1] = nx; }
        const unsigned old = xb_add(&bar[XB_XSUB(b.x)], 1u);
        const unsigned gen = old / nloc;
        if (old + 1u == (gen + 1u) * nloc) {
            __builtin_amdgcn_fence(__ATOMIC_RELEASE, "agent");
            asm volatile("s_waitcnt vmcnt(0)" ::: "memory");
            const unsigned og = xb_add(&bar[XB_TOP], 1u);
            const unsigned tg = og / nx;
            if (og + 1u == (tg + 1u) * nx) xb_add(&bar[XB_TOPGEN], 1u);
            else XB_SPIN(xb_ld(&bar[XB_TOPGEN]) == tg, bar);
            __builtin_amdgcn_fence(__ATOMIC_ACQUIRE, "agent");
            xb_add(&bar[XB_XGEN(b.x)], 1u);
            asm volatile("s_waitcnt vmcnt(0)" ::: "memory");
        } else {
            XB_SPIN(xb_ld(&bar[XB_XGEN(b.x)]) == gen, bar);
            __builtin_amdgcn_fence(__ATOMIC_ACQUIRE, "agent");
            asm volatile("s_waitcnt vmcnt(0)" ::: "memory");
        }
    }
    __syncthreads();
}

struct Params { const float* in[29]; float* out; unsigned char* ws; };
constexpr int LDS_ST_OFF = 135168;
constexpr int LDS_BYTES = 135168 + 64;

__device__ __forceinline__ unsigned char* opaque_p(unsigned char* p) { asm volatile("" : "+s"(p)); return p; }
__device__ __forceinline__ int opaque_s(int v) { asm volatile("" : "+s"(v)); return v; }
#define PH_BEGIN { const int tid = opaque((int)threadIdx.x), lane = tid & 63, wave = __builtin_amdgcn_readfirstlane(tid >> 6); \
    const int G = opaque_s((int)gridDim.x), bid = opaque_s((int)blockIdx.x); const int gw = bid * 8 + wave, NGW = G * 8, gt = bid * 512 + tid, NGT = G * 512; \
    unsigned char* ws = opaque_p(P.ws); LAS unsigned char* lds = (LAS unsigned char*)shm; LAS float* scr = (LAS float*)(lds + wave * 16640); \
    (void)lane; (void)gw; (void)NGW; (void)gt; (void)NGT; (void)ws; (void)scr; (void)G; (void)bid;
#define PH_END }
#define WS_BF(off) ((bf16_t*)(ws + (off)))
#define WS_F(off) ((float*)(ws + (off)))

__global__ void __launch_bounds__(512, 2) fwd_kernel(Params P) {
    extern __shared__ __attribute__((aligned(16))) unsigned char shm[];
    cg::grid_group grid = cg::this_grid();
    volatile LAS unsigned* xst = (volatile LAS unsigned*)((LAS unsigned char*)shm + LDS_ST_OFF);
    if (threadIdx.x == 0) { xst[0] = 0u; xst[1] = 0u; }
    __syncthreads();
    const XcdBarrier xb = xcd_barrier_post((unsigned*)(P.ws + OFF_BAR), xst);
#define GSYNC_CG() do { asm volatile("s_waitcnt vmcnt(0) lgkmcnt(0)" ::: "memory"); __threadfence(); asm volatile("s_waitcnt vmcnt(0)" ::: "memory"); grid.sync(); \
    __builtin_amdgcn_fence(__ATOMIC_ACQUIRE, "agent"); asm volatile("s_waitcnt vmcnt(0)" ::: "memory"); } while (0)
#define GSYNC() xcd_barrier(xb)
    grid.sync();
    float* hres = P.out;

#pragma unroll 1
    for (int l = 0; l < 2; ++l) {
        const float* hin = (l == 0) ? P.in[0] : hres;
        PH_BEGIN
        for (int it = bid; it < 256; it += G)
            s5_prep_item(it >> 2, it & 3, P.in[4] + l * 4096, P.in[5] + l * 4096, P.in[6] + l * 64, P.in[7] + (size_t)l * 65536, P.in[8] + (size_t)l * 65536,
                         P.in[9] + (size_t)l * 65536, P.in[10] + (size_t)l * 65536, WS_F(OFF_PTAB), WS_F(OFF_KTAU), WS_BF(OFF_M2), (LAS float*)lds, tid);
        PH_END
        PH_BEGIN transpose_matrix(P.in[2] + (size_t)l * 2048 * INC, 2048, INC, WS_BF(OFF_WIN), scr, gw, NGW, lane, P.in[1] + l * 2048); PH_END
        PH_BEGIN transpose_matrix(P.in[12] + (size_t)l * 1024 * 1024, 1024, 1024, WS_BF(OFF_WGLU), scr, gw, NGW, lane); PH_END
        PH_BEGIN transpose_matrix(P.in[21] + (size_t)l * 1024 * 2048, 1024, 2048, WS_BF(OFF_WBR), scr, gw, NGW, lane); PH_END
        PH_BEGIN transpose_matrix(P.in[22] + (size_t)l * 1024 * 2048, 1024, 2048, WS_BF(OFF_WBR) + (size_t)2048 * 1024, scr, gw, NGW, lane); PH_END
        PH_BEGIN transpose_matrix(P.in[23] + (size_t)l * 1024 * 2048, 1024, 2048, WS_BF(OFF_WBR) + (size_t)2 * 2048 * 1024, scr, gw, NGW, lane); PH_END
        PH_BEGIN transpose_matrix(P.in[24] + (size_t)l * 2048 * 2048, 2048, 2048, WS_BF(OFF_WOUT), scr, gw, NGW, lane); PH_END
        PH_BEGIN lru_fill_w(P.in[16] + (size_t)l * 65536, P.in[18] + (size_t)l * 65536, WS_BF(OFF_WLRU), gt, NGT); PH_END
        if (l == 0) { PH_BEGIN x_prep_rows(hin, WS_BF(OFF_X2), WS_F(OFF_RSTD), gw, NGW, lane); PH_END }
        else { PH_BEGIN rstd_rows(WS_F(OFF_PART), WS_F(OFF_RSTD), gt, NGT); PH_END }
        GSYNC();
        PH_BEGIN pg8::Gemm g{WS_BF(OFF_X2), WS_BF(OFF_WIN), T_TOK, INC, 2048, 2048, 2048}; pg8::StaticOrder S; S.init(T_TOK, INC, G, bid);
          EpiInProj E{WS_BF(OFF_A5), WS_BF(OFF_ULRU), WS_BF(OFF_R3), WS_BF(OFF_GATES), P.in[3] + l * 6144, WS_F(OFF_RSTD)}; pg8::gemm_phase(lds, g, S, E); PH_END
        GSYNC();
        PH_BEGIN pg8::Gemm g{WS_BF(OFF_A5), WS_BF(OFF_M2), 65536, 16384, 256, 384, 256}; pg8::BatchOrder S; S.init(G, bid); EpiS5A E{WS_F(OFF_SEND)}; pg8::gemm_phase(lds, g, S, E); PH_END
        PH_BEGIN s5_panel_scan(WS_F(OFF_SEND), WS_F(OFF_PTAB), WS_BF(OFF_A5), lds, (G % 8 == 0) ? (bid % 8) * (G / 8) + bid / 8 : bid, G, tid); PH_END
        PH_BEGIN lru_conv(WS_BF(OFF_ULRU), P.in[14] + l * 4096, P.in[15] + l * 1024, WS_BF(OFF_XC), gt, NGT); PH_END
        PH_BEGIN s5_fill_m13(WS_F(OFF_KTAU), WS_F(OFF_PTAB), P.in[9] + (size_t)l * 65536, P.in[10] + (size_t)l * 65536, WS_BF(OFF_M13), gt, NGT); PH_END
        PH_BEGIN
        for (int id = ((G % 8 == 0) ? (bid % 8) * (G / 8) + bid / 8 : bid) * 8 + wave; id < 4096; id += NGW) { const int bh = id >> 7, qt = id & 127;
            attn_task(WS_BF(OFF_R3), WS_BF(OFF_R3) + (size_t)T_TOK * 1024, WS_BF(OFF_R3) + (size_t)2 * T_TOK * 1024, WS_BF(OFF_YATT), bh >> 3, bh & 7, qt, lds + wave * 16384, lane); }
        PH_END
        GSYNC();
        PH_BEGIN pg8::Gemm g{WS_BF(OFF_A5), WS_BF(OFF_M13), 65536, 16384, 384, 384, 384}; pg8::BatchOrder S; S.init(G, bid); EpiS5B E{WS_BF(OFF_A5), P.in[11] + l * 1024, WS_BF(OFF_YPRE)}; pg8::gemm_phase(lds, g, S, E); PH_END
        PH_BEGIN pg8::Gemm g{WS_BF(OFF_XC), WS_BF(OFF_WLRU), T_TOK, 2048, 256, 1024, 256, 256}; pg8::StaticOrder S; S.init(T_TOK, 2048, G, bid);
          EpiLruGate E{WS_BF(OFF_XC), P.in[17] + l * 1024, P.in[19] + l * 1024, P.in[20] + l * 1024, WS_F(OFF_R3), WS_F(OFF_R3 + 64 * MiB), WS_F(OFF_SUMA), WS_F(OFF_SUMH)}; pg8::gemm_phase(lds, g, S, E); PH_END
        GSYNC();
        PH_BEGIN pg8::Gemm g{WS_BF(OFF_YPRE), WS_BF(OFF_WGLU), T_TOK, 1024, 1024, 1024, 1024}; pg8::StaticOrder S; S.init(T_TOK, 1024, G, bid);
          EpiGlu E{WS_BF(OFF_YPRE), P.in[13] + l * 1024, WS_BF(OFF_ULRU)}; pg8::gemm_phase(lds, g, S, E); PH_END
        PH_BEGIN lru_fixup(WS_F(OFF_R3), WS_F(OFF_R3 + 64 * MiB), WS_F(OFF_SUMA), WS_F(OFF_SUMH), WS_BF(OFF_SEND), gw, NGW, lane); PH_END
        GSYNC();
        PH_BEGIN pg8::MergeOrder S; S.init(T_TOK, 2048, G, bid);
          pg8::Gemm g{WS_BF(OFF_ULRU), WS_BF(OFF_WBR), T_TOK, 2048, 1024, 1024, 1024, 0, (size_t)(OFF_SEND - OFF_ULRU), 8};
          EpiMerge E{WS_BF(OFF_GATES), WS_BF(OFF_X2)}; pg8::gemm_phase(lds, g, S, E); PH_END
        GSYNC();
        PH_BEGIN pg8::Gemm g{WS_BF(OFF_X2), WS_BF(OFF_WOUT), T_TOK, 2048, 2048, 2048, 2048}; pg8::StaticOrder S; S.init(T_TOK, 2048, G, bid); EpiResid E{hin, hres, WS_BF(OFF_XC), WS_F(OFF_PART)}; pg8::gemm_phase(lds, g, S, E); PH_END
        GSYNC();
        PH_BEGIN transpose_matrix(P.in[26] + (size_t)l * 2048 * DFF, 2048, DFF, WS_BF(OFF_R3), scr, gw, NGW, lane, P.in[25] + l * 2048); PH_END
        PH_BEGIN transpose_matrix(P.in[27] + (size_t)l * DFF * 2048, DFF, 2048, WS_BF(OFF_R3 + 32 * MiB), scr, gw, NGW, lane); PH_END
        PH_BEGIN rstd_rows(WS_F(OFF_PART), WS_F(OFF_RSTD), gt, NGT); PH_END
        GSYNC();
        PH_BEGIN pg8::Gemm g{WS_BF(OFF_XC), WS_BF(OFF_R3), T_TOK, DFF, 2048, 2048, 2048}; pg8::StaticOrder S; S.init(T_TOK, DFF, G, bid); EpiUp E{WS_BF(OFF_HDN), WS_F(OFF_RSTD)}; pg8::gemm_phase(lds, g, S, E); PH_END
        GSYNC();
        PH_BEGIN pg8::Gemm g{WS_BF(OFF_HDN), WS_BF(OFF_R3 + 32 * MiB), T_TOK, 2048, DFF, DFF, DFF}; pg8::StaticOrder S; S.init(T_TOK, 2048, G, bid); EpiResid E{hres, hres, WS_BF(OFF_X2), WS_F(OFF_PART)}; pg8::gemm_phase(lds, g, S, E); PH_END
        GSYNC();
    }
    PH_BEGIN rmsnorm_rows<true>(hres, P.in[28], hres, gw, NGW, lane); PH_END
}

extern "C" void kernel_launch(void* const* d_in, const int* in_sizes, int n_in, void* d_out, int out_size, void* d_ws, size_t ws_size, hipStream_t stream) {
    static int grid = 0;
    if (grid == 0) {
        if (n_in != 29 || out_size != T_TOK * DM || ws_size < OFF_END) { fprintf(stderr, "kernel_launch: unexpected shapes (n_in %d out %d ws %zu need %zu)\n", n_in, out_size, ws_size, (size_t)OFF_END); grid = -1; return; }
        int dev = 0, cus = 0, per_cu = 0;
        hipGetDevice(&dev); hipDeviceGetAttribute(&cus, hipDeviceAttributeMultiprocessorCount, dev);
        if (hipFuncSetAttribute((const void*)fwd_kernel, hipFuncAttributeMaxDynamicSharedMemorySize, LDS_BYTES) != hipSuccess) { fprintf(stderr, "kernel_launch: hipFuncSetAttribute failed\n"); grid = -1; return; }
        hipOccupancyMaxActiveBlocksPerMultiprocessor(&per_cu, (const void*)fwd_kernel, 512, LDS_BYTES);
        if (per_cu < 1) { fprintf(stderr, "kernel_launch: occupancy query says %d blocks per CU\n", per_cu); per_cu = 1; }
        grid = cus * 1;
        (void)hipGetLastError();
    }
    if (grid < 0) return;
    if (hipMemsetAsync((char*)d_ws + OFF_BAR, 0, 16384, stream) != hipSuccess) { fprintf(stderr, "kernel_launch: memset of barrier words failed\n"); return; }
    Params p{};
    for (int i = 0; i < 29; ++i) p.in[i] = (const float*)d_in[i];
    p.out = (float*)d_out; p.ws = (unsigned char*)d_ws;
    void* args[] = {&p};
    hipError_t e = hipLaunchCooperativeKernel((const void*)fwd_kernel, dim3(grid), dim3(512), args, LDS_BYTES, stream);
    if (e != hipSuccess) fprintf(stderr, "cooperative launch failed: %s (grid %d)\n", hipGetErrorString(e), grid);
}
```

```cpp
#include <hip/hip_runtime.h>
#include <hip/hip_cooperative_groups.h>
#include <cstdio>
#include <cstdint>
namespace cg = cooperative_groups;

#define LAS __attribute__((address_space(3)))
typedef unsigned short bf16_t;
typedef short bf16x8 __attribute__((ext_vector_type(8)));
typedef float f32x4 __attribute__((ext_vector_type(4)));
typedef float f32x16 __attribute__((ext_vector_type(16)));
typedef unsigned u32x4 __attribute__((ext_vector_type(4)));
typedef unsigned u32x2 __attribute__((ext_vector_type(2)));

constexpr int T_TOK = 16384, SEQ = 4096, NB = 4, DM = 2048, DFF = 8192, INC = 11264;
constexpr float EPSN = 1e-6f;

constexpr size_t MiB = 1u << 20;
constexpr size_t OFF_PTAB = 0;
constexpr size_t OFF_KTAU = 1 * MiB;
constexpr size_t OFF_SUMA = 2 * MiB;
constexpr size_t OFF_SUMH = 3 * MiB;
constexpr size_t OFF_BAR = 5 * MiB;
constexpr size_t OFF_PART = 6 * MiB;
constexpr size_t OFF_RSTD = 4 * MiB + 65536;
constexpr size_t OFF_W = 8 * MiB;
constexpr size_t OFF_WIN = OFF_W;
constexpr size_t OFF_WGLU = OFF_WIN + 44 * MiB;
constexpr size_t OFF_WBR = OFF_WGLU + 2 * MiB;
constexpr size_t OFF_WOUT = OFF_WBR + 12 * MiB;
constexpr size_t OFF_WLRU = OFF_WOUT + 8 * MiB;
constexpr size_t OFF_M2 = OFF_WLRU + 4 * MiB;
constexpr size_t OFF_M13 = OFF_M2 + 8 * MiB;
constexpr size_t OFF_GATES = OFF_M13 + 12 * MiB;
constexpr size_t OFF_A5 = OFF_GATES + 192 * MiB;
constexpr size_t OFF_ULRU = OFF_A5 + 48 * MiB;
constexpr size_t OFF_XC = OFF_ULRU + 32 * MiB;
constexpr size_t OFF_SEND = OFF_XC + 32 * MiB;
constexpr size_t OFF_YPRE = OFF_SEND + 32 * MiB;
constexpr size_t OFF_YATT = OFF_YPRE + 32 * MiB;
constexpr size_t OFF_X2 = OFF_YATT + 32 * MiB;
constexpr size_t OFF_R3 = OFF_X2 + 64 * MiB;
constexpr size_t OFF_END = OFF_R3 + 128 * MiB;
constexpr size_t OFF_HDN = OFF_GATES;
static_assert(OFF_HDN + 256 * MiB <= OFF_X2, "hdn overlay");
static_assert(OFF_SEND - OFF_ULRU == OFF_YATT - OFF_SEND, "the three merge operands must be equally spaced");

typedef float f32x2_t __attribute__((ext_vector_type(2)));
typedef __bf16 bf16x2_t __attribute__((ext_vector_type(2)));
__device__ __forceinline__ unsigned cvt_pk_bf16(float lo, float hi) { f32x2_t v = {lo, hi}; bf16x2_t b = __builtin_convertvector(v, bf16x2_t); return __builtin_bit_cast(unsigned, b); }
__device__ __forceinline__ float bf2f(unsigned short b) { return __uint_as_float(((unsigned)b) << 16); }
__device__ __forceinline__ float bflo(unsigned w) { return __uint_as_float(w << 16); }
__device__ __forceinline__ float bfhi(unsigned w) { return __uint_as_float(w & 0xffff0000u); }
__device__ __forceinline__ unsigned short f2bf(float f) { unsigned u = __float_as_uint(f); return (unsigned short)((u + 0x7fffu + ((u >> 16) & 1u)) >> 16); }
__device__ __forceinline__ float sigmoid_f(float x) { return __builtin_amdgcn_rcpf(1.f + __expf(-x)); }
__device__ __forceinline__ int opaque(int v) { asm volatile("" : "+v"(v)); return v; }
__device__ __forceinline__ float wave_sum(float v) {
#pragma unroll
    for (int o = 1; o < 64; o <<= 1) v += __shfl_xor(v, o);
    return v;
}

namespace pg8 {
constexpr int BM = 256, BK = 64, HALF = 128, HTB = HALF * BK * 2, STAGE_BYTES = 8 * HTB, NXCD = 8, WGM = 2;
__host__ __device__ __forceinline__ int lds_byte(int r, int c) { const int st = (r >> 4) * 2 + (c >> 5), rr = r & 15, cc = c & 31, ob = rr * 64 + cc * 2; return st * 1024 + (ob ^ (((ob >> 9) & 1) << 5)); }
__host__ __device__ __forceinline__ void stage_rc(int b, int& R, int& C) { const int st = b / 1024, sb = b % 1024, swz = sb ^ (((sb >> 9) & 1) << 5); R = (st >> 1) * 16 + swz / 64; C = (st & 1) * 32 + (swz % 64) / 2; }
__host__ __device__ __forceinline__ int perm32(int rho) { const int n = rho >> 4, i = rho & 15; return 8 * (i >> 2) + 4 * n + (i & 3); }

struct Unit { int pm, pn, br; };
struct Gemm { const bf16_t* A; const bf16_t* Bt; int M, N, K, lda, ldb, akw; size_t astride; int bpan; };

struct StaticOrder {
    int nM, nN, nwg, G, c;
    __device__ void init(int M, int N, int G_, int c_) { nM = M / BM; nN = N / BM; nwg = nM * nN; G = G_; c = c_; }
    __device__ bool next(int i, Unit& u) const {
        const long L = (long)i * G + c; if (L >= nwg) return false;
        int wgid = (int)L; { const int q = nwg / NXCD, r = nwg % NXCD, xcd = wgid % NXCD, off = wgid / NXCD; wgid = (xcd < r ? xcd * (q + 1) : r * (q + 1) + (xcd - r) * q) + off; }
        const int nig = WGM * nN, gid = wgid / nig, fm = gid * WGM, gsz = (nM - fm) < WGM ? (nM - fm) : WGM;
        u.pm = fm + ((wgid % nig) % gsz); u.pn = (wgid % nig) / gsz; u.br = 0; return true;
    }
};
struct MergeOrder {
    StaticOrder so;
    __device__ void init(int M, int N, int G_, int c_) { so.init(M, N, G_, c_); }
    __device__ bool next(int i, Unit& u) const { if (!so.next(i / 3, u)) return false; u.br = i % 3; return true; }
};
struct BatchOrder {
    int G, c;
    __device__ void init(int G_, int c_) { G = G_; c = (G_ % 8 == 0) ? (c_ % 8) * (G_ / 8) + c_ / 8 : c_; }
    __device__ bool next(int i, Unit& u) const { const int L = i * G + c; if (L >= 256) return false; u.pm = L; u.pn = L >> 2; u.br = 0; return true; }
};

template <class Epi, class Sched, bool ALIGN_EPI = true, bool SP2 = true>
__device__ __forceinline__ void gemm_phase(LAS unsigned char* lds, const Gemm g, const Sched& S, const Epi& E) {
    const int tid = opaque((int)threadIdx.x), wid = __builtin_amdgcn_readfirstlane(tid >> 6), lane = tid & 63, wr = wid >> 2, wc = wid & 3, fr = lane & 15, fq = lane >> 4;
    int Kv = g.K; asm volatile("" : "+s"(Kv)); const int K = Kv, nt = K / BK;
    unsigned voffA[2], voffB[2];
#pragma unroll
    for (int i = 0; i < 2; ++i) { int R, C; stage_rc(tid * 16 + i * 8192, R, C); const int Rb = Epi::PERM ? ((R & ~31) + perm32(R & 31)) : R;
        voffA[i] = (unsigned)(R * g.lda + C) * 2u; voffB[i] = (unsigned)(Rb * g.ldb + C) * 2u; }
    const size_t kstep = (size_t)(BK * 2);
    const size_t hA = (size_t)HALF * g.lda * 2, hB = (size_t)HALF * g.ldb * 2;
    const size_t tA = 2 * hA, tB = 2 * hB;
    const unsigned ldsw = (unsigned)wid * 1024u;
    const int aoff = lds_byte(wr * 64 + fr, fq * 8), boff = lds_byte(wc * 32 + fr, fq * 8);
#define PG8_SA(b, h) (((b) * 2 + (h)) * HTB)
#define PG8_SB(b, h) ((4 + (b) * 2 + (h)) * HTB)
#define PG8_STAGE(bufoff, gbase, voff) do { _Pragma("unroll") for (int _i = 0; _i < 2; ++_i) \
        __builtin_amdgcn_global_load_lds((const unsigned*)((const char*)(gbase) + (voff)[_i]), (LAS unsigned*)(lds + (bufoff) + ldsw + _i * 8192), 16, 0, 0); } while (0)
#define PG8_LDA(dst, b, h) do { _Pragma("unroll") for (int m = 0; m < 4; ++m) _Pragma("unroll") for (int k = 0; k < 2; ++k) dst[m][k] = *(const LAS bf16x8*)(lds + PG8_SA(b, h) + aoff + m * 2048 + k * 1024); } while (0)
#define PG8_LDB(dst, b, h) do { _Pragma("unroll") for (int n = 0; n < 2; ++n) _Pragma("unroll") for (int k = 0; k < 2; ++k) dst[n][k] = *(const LAS bf16x8*)(lds + PG8_SB(b, h) + boff + n * 2048 + k * 1024); } while (0)
#define PG8_MMA(ai, bj, At, Bt) do { __builtin_amdgcn_s_setprio(1); _Pragma("unroll") for (int m = 0; m < 4; ++m) _Pragma("unroll") for (int n = 0; n < 2; ++n) _Pragma("unroll") for (int k = 0; k < 2; ++k) \
        acc[ai][bj][m][n] = __builtin_amdgcn_mfma_f32_16x16x32_bf16(Bt[n][k], At[m][k], acc[ai][bj][m][n], 0, 0, 0); __builtin_amdgcn_s_setprio(0); } while (0)
#define PG8_WAIT_V(n) asm volatile("s_waitcnt vmcnt(" #n ")" ::: "memory")
#define PG8_WAIT_L(n) asm volatile("s_waitcnt lgkmcnt(" #n ")" ::: "memory")
#define PG8_BAR __builtin_amdgcn_s_barrier()
#define PG8_SCHED __builtin_amdgcn_sched_barrier(0)
    Unit cur, nxt; int ui = 0;
    if (!S.next(0, cur)) return;
    f32x4 acc[2][2][4][2];
    if constexpr (Epi::INIT) E.init(acc, cur, wr, wc, fr, fq);
    else {
#pragma unroll
    for (int a = 0; a < 2; ++a)
#pragma unroll
        for (int b = 0; b < 2; ++b)
#pragma unroll
            for (int m = 0; m < 4; ++m)
#pragma unroll
                for (int n = 0; n < 2; ++n) acc[a][b][m][n] = (f32x4){0.f, 0.f, 0.f, 0.f};
    }
    bf16x8 At[4][2], B0[2][2], B1[2][2];
    const char* cA = (const char*)g.A + (size_t)cur.br * g.astride + (size_t)cur.pm * tA + (size_t)((cur.pn >> 1) * g.akw) * 2; const char* cB = (const char*)g.Bt + (size_t)(cur.br * g.bpan + cur.pn) * tB;
    if constexpr (SP2) {
        PG8_STAGE(PG8_SB(0, 0), cB, voffB); PG8_STAGE(PG8_SB(0, 1), cB + hB, voffB); PG8_STAGE(PG8_SA(0, 0), cA, voffA); PG8_STAGE(PG8_SA(0, 1), cA + hA, voffA);
        if (wr == 1) PG8_BAR;
        PG8_WAIT_V(2); PG8_BAR;
        PG8_STAGE(PG8_SB(1, 0), cB + kstep, voffB); PG8_STAGE(PG8_SA(1, 0), cA + kstep, voffA); PG8_STAGE(PG8_SB(1, 1), cB + hB + kstep, voffB);
        PG8_WAIT_V(6); PG8_BAR;
    } else {
        PG8_STAGE(PG8_SB(0, 0), cB, voffB); PG8_STAGE(PG8_SA(0, 0), cA, voffA); PG8_STAGE(PG8_SB(0, 1), cB + hB, voffB); PG8_STAGE(PG8_SA(0, 1), cA + hA, voffA);
        if (wr == 1) PG8_BAR;
        PG8_WAIT_V(4); PG8_BAR;
        PG8_STAGE(PG8_SB(1, 0), cB + kstep, voffB); PG8_STAGE(PG8_SA(1, 0), cA + kstep, voffA); PG8_STAGE(PG8_SB(1, 1), cB + hB + kstep, voffB);
        PG8_WAIT_V(6); PG8_BAR;
    }
    for (;;) {
        const bool has_next = S.next(ui + 1, nxt);
        const char* nA = has_next ? (const char*)g.A + (size_t)nxt.br * g.astride + (size_t)nxt.pm * tA + (size_t)((nxt.pn >> 1) * g.akw) * 2 : cA; const char* nB = has_next ? (const char*)g.Bt + (size_t)(nxt.br * g.bpan + nxt.pn) * tB : cB;
        for (int t = 0; t < nt; t += 2) {
            const bool last = (t == nt - 2);
            const char* a1 = cA + (size_t)(t + 1) * kstep;
            const char* a2 = last ? nA : cA + (size_t)(t + 2) * kstep; const char* b2 = last ? nB : cB + (size_t)(t + 2) * kstep;
            const char* a3 = a2 + kstep; const char* b3 = b2 + kstep;
            if constexpr (SP2) {
            PG8_LDB(B0, 0, 0); PG8_LDB(B1, 0, 1); PG8_SCHED; PG8_LDA(At, 0, 0); PG8_STAGE(PG8_SA(1, 1), a1 + hA, voffA);
            PG8_WAIT_V(8); PG8_WAIT_L(0); PG8_BAR; PG8_MMA(0, 0, At, B0); PG8_MMA(0, 1, At, B1); PG8_BAR; PG8_SCHED;
            PG8_LDA(At, 0, 1); PG8_STAGE(PG8_SB(0, 0), b2, voffB); PG8_STAGE(PG8_SB(0, 1), b2 + hB, voffB); PG8_STAGE(PG8_SA(0, 0), a2, voffA);
            PG8_WAIT_V(8); PG8_WAIT_L(0); PG8_BAR; PG8_MMA(1, 0, At, B0); PG8_MMA(1, 1, At, B1); PG8_BAR; PG8_SCHED;
            PG8_LDB(B0, 1, 0); PG8_LDB(B1, 1, 1); PG8_SCHED; PG8_LDA(At, 1, 0); PG8_STAGE(PG8_SA(0, 1), a2 + hA, voffA);
            PG8_WAIT_V(8); PG8_WAIT_L(0); PG8_BAR; PG8_MMA(0, 0, At, B0); PG8_MMA(0, 1, At, B1); PG8_BAR; PG8_SCHED;
            PG8_LDA(At, 1, 1); PG8_STAGE(PG8_SB(1, 0), b3, voffB); PG8_STAGE(PG8_SB(1, 1), b3 + hB, voffB); PG8_STAGE(PG8_SA(1, 0), a3, voffA);
            PG8_WAIT_V(8); PG8_WAIT_L(0); PG8_BAR; PG8_MMA(1, 0, At, B0); PG8_MMA(1, 1, At, B1); PG8_BAR; PG8_SCHED;
            } else {
            PG8_LDB(B0, 0, 0); PG8_SCHED; PG8_LDA(At, 0, 0); PG8_STAGE(PG8_SA(1, 1), a1 + hA, voffA);
            PG8_WAIT_L(8); PG8_BAR; PG8_WAIT_L(0); PG8_MMA(0, 0, At, B0); PG8_BAR; PG8_SCHED;
            PG8_LDB(B1, 0, 1); PG8_STAGE(PG8_SB(0, 0), b2, voffB);
            PG8_BAR; PG8_WAIT_L(0); PG8_MMA(0, 1, At, B1); PG8_BAR;
            PG8_LDA(At, 0, 1); PG8_STAGE(PG8_SA(0, 0), a2, voffA);
            PG8_BAR; PG8_WAIT_L(0); PG8_MMA(1, 0, At, B0); PG8_BAR; PG8_SCHED;
            PG8_STAGE(PG8_SB(0, 1), b2 + hB, voffB);
            PG8_WAIT_V(6); PG8_BAR; PG8_MMA(1, 1, At, B1); PG8_BAR;
            PG8_LDB(B0, 1, 0); PG8_SCHED; PG8_LDA(At, 1, 0); PG8_STAGE(PG8_SA(0, 1), a2 + hA, voffA);
            PG8_WAIT_L(8); PG8_BAR; PG8_WAIT_L(0); PG8_MMA(0, 0, At, B0); PG8_BAR; PG8_SCHED;
            PG8_LDB(B1, 1, 1); PG8_STAGE(PG8_SB(1, 0), b3, voffB);
            PG8_BAR; PG8_WAIT_L(0); PG8_MMA(0, 1, At, B1); PG8_BAR;
            PG8_LDA(At, 1, 1); PG8_STAGE(PG8_SA(1, 0), a3, voffA);
            PG8_BAR; PG8_WAIT_L(0); PG8_MMA(1, 0, At, B0); PG8_BAR; PG8_SCHED;
            PG8_STAGE(PG8_SB(1, 1), b3 + hB, voffB);
            PG8_WAIT_V(6); PG8_BAR; PG8_MMA(1, 1, At, B1); PG8_BAR;
            }
        }
        if constexpr (ALIGN_EPI) { if (wr == 0) PG8_BAR; }
        if constexpr (Epi::KEEP) E.apply(acc, cur, wr, wc, fr, fq); else E(acc, cur, wr, wc, fr, fq);
        if (!has_next) break;
        if constexpr (Epi::INIT) E.init(acc, nxt, wr, wc, fr, fq);
        else if (!Epi::KEEP || nxt.br == 0) {
#pragma unroll
        for (int a = 0; a < 2; ++a)
#pragma unroll
            for (int b = 0; b < 2; ++b)
#pragma unroll
                for (int m = 0; m < 4; ++m)
#pragma unroll
                    for (int n = 0; n < 2; ++n) acc[a][b][m][n] = (f32x4){0.f, 0.f, 0.f, 0.f};
        }
        cur = nxt; cA = nA; cB = nB; ++ui;
        if constexpr (ALIGN_EPI) { if (wr == 1) PG8_BAR; }
    }
    PG8_WAIT_V(0);
    if constexpr (!ALIGN_EPI) { if (wr == 0) PG8_BAR; }
    PG8_BAR;
#undef PG8_SA
#undef PG8_SB
#undef PG8_STAGE
#undef PG8_LDA
#undef PG8_LDB
#undef PG8_MMA
#undef PG8_WAIT_V
#undef PG8_WAIT_L
#undef PG8_BAR
#undef PG8_SCHED
}
}
using pg8::Unit;

#define EPI_LOOP_AM _Pragma("unroll") for (int ai = 0; ai < 2; ++ai) _Pragma("unroll") for (int m = 0; m < 4; ++m)
__device__ __forceinline__ u32x4 pack8(const f32x4& a, const f32x4& b) { u32x4 o; o.x = cvt_pk_bf16(a[0], a[1]); o.y = cvt_pk_bf16(a[2], a[3]); o.z = cvt_pk_bf16(b[0], b[1]); o.w = cvt_pk_bf16(b[2], b[3]); return o; }
__device__ __forceinline__ void unpack8(const u32x4& v, float (&f)[8]) { f[0] = bflo(v.x); f[1] = bfhi(v.x); f[2] = bflo(v.y); f[3] = bfhi(v.y); f[4] = bflo(v.z); f[5] = bfhi(v.z); f[6] = bflo(v.w); f[7] = bfhi(v.w); }

struct EpiInProj {
    static constexpr bool PERM = true, INIT = false, KEEP = false;
    bf16_t* A5; bf16_t* ulru; bf16_t* qkv; bf16_t* gates; const float* bgate; const float* rstd;
    __device__ __forceinline__ void operator()(const f32x4 (&acc)[2][2][4][2], const Unit& u, int wr, int wc, int fr, int fq) const {
        const int row0 = u.pm * 256 + wr * 64 + fr, cl0 = wc * 32 + 8 * fq, pn = u.pn;
        if (pn < 4) {
            EPI_LOOP_AM { const int row = row0 + ai * 128 + m * 16, b = row >> 12, t = row & 4095, chunk = t >> 4, s = t & 15; const float rs = rstd[row];
#pragma unroll
                for (int bj = 0; bj < 2; ++bj) { const int ch = pn * 256 + bj * 128 + cl0, g = ch >> 4, c0 = ch & 15;
                    *(u32x4*)(A5 + ((size_t)((g * 4 + b) * 256 + chunk)) * 384 + s * 16 + c0) = pack8(acc[ai][bj][m][0] * rs, acc[ai][bj][m][1] * rs); } }
        } else if (pn < 8) {
            EPI_LOOP_AM { const int row = row0 + ai * 128 + m * 16; const float rs = rstd[row];
#pragma unroll
                for (int bj = 0; bj < 2; ++bj) *(u32x4*)(ulru + (size_t)row * 1024 + (pn - 4) * 256 + bj * 128 + cl0) = pack8(acc[ai][bj][m][0] * rs, acc[ai][bj][m][1] * rs); }
        } else if (pn < 20) {
            const int which = (pn - 8) >> 2, cb = ((pn - 8) & 3) * 256; bf16_t* base = qkv + (size_t)which * T_TOK * 1024;
            EPI_LOOP_AM { const int row = row0 + ai * 128 + m * 16; const float rs = rstd[row];
#pragma unroll
                for (int bj = 0; bj < 2; ++bj) *(u32x4*)(base + (size_t)row * 1024 + cb + bj * 128 + cl0) = pack8(acc[ai][bj][m][0] * rs, acc[ai][bj][m][1] * rs); }
        } else {
            const int gc0 = (pn - 20) * 256 + cl0;
            f32x4 bv[2][2];
#pragma unroll
            for (int bj = 0; bj < 2; ++bj)
#pragma unroll
                for (int n = 0; n < 2; ++n) bv[bj][n] = *(const f32x4*)(bgate + gc0 + bj * 128 + 4 * n);
            EPI_LOOP_AM { const int row = row0 + ai * 128 + m * 16; const float rs = rstd[row];
#pragma unroll
                for (int bj = 0; bj < 2; ++bj) { f32x4 v0 = acc[ai][bj][m][0] * rs + bv[bj][0], v1 = acc[ai][bj][m][1] * rs + bv[bj][1];
#pragma unroll
                    for (int j = 0; j < 4; ++j) { v0[j] = sigmoid_f(v0[j]); v1[j] = sigmoid_f(v1[j]); }
                    *(u32x4*)(gates + (size_t)row * 6144 + gc0 + bj * 128) = pack8(v0, v1); } }
        }
    }
};

struct EpiS5A {
    static constexpr bool PERM = false, INIT = false, KEEP = false;
    float* send;
    __device__ __forceinline__ void operator()(const f32x4 (&acc)[2][2][4][2], const Unit& u, int wr, int wc, int fr, int fq) const {
        const int row0 = u.pm * 256 + wr * 64 + fr, col0 = wc * 32 + 4 * fq;
        EPI_LOOP_AM { float* rp = send + (size_t)(row0 + ai * 128 + m * 16) * 128 + col0;
#pragma unroll
            for (int n = 0; n < 2; ++n) *(f32x4*)(rp + n * 16) = acc[ai][0][m][n]; }
    }
};

struct EpiS5B {
    static constexpr bool PERM = true, INIT = false, KEEP = false;
    const bf16_t* A5; const float* dsk; bf16_t* ypre;
    __device__ __forceinline__ void operator()(const f32x4 (&acc)[2][2][4][2], const Unit& u, int wr, int wc, int fr, int fq) const {
        const int g = u.pm >> 2, b = u.pm & 3, cl0 = wc * 32 + 8 * fq, c0 = (8 * fq) & 15;
        float dv[8];
#pragma unroll
        for (int e = 0; e < 8; ++e) dv[e] = dsk[g * 16 + c0 + e];
        const int chunk0 = wr * 64 + fr;
        const bf16_t* ub = A5 + ((size_t)u.pm * 256 + chunk0) * 384 + cl0;
        bf16_t* yb = ypre + ((size_t)(b * 4096 + chunk0 * 16 + (cl0 >> 4))) * 1024 + g * 16 + c0;
        EPI_LOOP_AM {
#pragma unroll
            for (int bj = 0; bj < 2; ++bj) {
                const u32x4 uu = *(const u32x4*)(ub + (size_t)(ai * 128 + m * 16) * 384 + bj * 128); float uf[8]; unpack8(uu, uf);
                f32x4 v0, v1;
#pragma unroll
                for (int j = 0; j < 4; ++j) { float y = acc[ai][bj][m][0][j] + dv[j] * uf[j]; float a = 0.7978845608028654f * (y + 0.044715f * y * y * y); v0[j] = y * sigmoid_f(2.f * a);
                    y = acc[ai][bj][m][1][j] + dv[4 + j] * uf[4 + j]; a = 0.7978845608028654f * (y + 0.044715f * y * y * y); v1[j] = y * sigmoid_f(2.f * a); }
                *(u32x4*)(yb + ((size_t)((ai * 128 + m * 16) * 16 + bj * 8)) * 1024) = pack8(v0, v1); } }
    }
};

struct EpiGlu {
    static constexpr bool PERM = true, INIT = false, KEEP = false;
    const bf16_t* ypre; const float* bglu; bf16_t* ys5;
    __device__ __forceinline__ void operator()(const f32x4 (&acc)[2][2][4][2], const Unit& u, int wr, int wc, int fr, int fq) const {
        const int row0 = u.pm * 256 + wr * 64 + fr, col0 = u.pn * 256 + wc * 32 + 8 * fq;
        f32x4 bv[2][2];
#pragma unroll
        for (int bj = 0; bj < 2; ++bj)
#pragma unroll
            for (int n = 0; n < 2; ++n) bv[bj][n] = *(const f32x4*)(bglu + col0 + bj * 128 + 4 * n);
        EPI_LOOP_AM { const size_t ro = (size_t)(row0 + ai * 128 + m * 16) * 1024 + col0;
#pragma unroll
            for (int bj = 0; bj < 2; ++bj) { const u32x4 yy = *(const u32x4*)(ypre + ro + bj * 128); float yf[8]; unpack8(yy, yf);
                f32x4 v0 = acc[ai][bj][m][0] + bv[bj][0], v1 = acc[ai][bj][m][1] + bv[bj][1];
#pragma unroll
                for (int j = 0; j < 4; ++j) { v0[j] = yf[j] * sigmoid_f(v0[j]); v1[j] = yf[4 + j] * sigmoid_f(v1[j]); }
                *(u32x4*)(ys5 + ro + bj * 128) = pack8(v0, v1); } }
    }
};

template <int D> __device__ __forceinline__ float dpp_row_shr(float idv, float v) {
    return __builtin_bit_cast(float, __builtin_amdgcn_update_dpp(__builtin_bit_cast(int, idv), __builtin_bit_cast(int, v), 0x110 + D, 0xf, 0xf, false)); }
#define LRU_SCAN_STEP(D) do { const float Ap = dpp_row_shr<D>(1.f, A), Hp = dpp_row_shr<D>(0.f, H); H = A * Hp + H; A = A * Ap; } while (0)
struct EpiLruGate {
    static constexpr bool PERM = true, INIT = false, KEEP = false;
    const bf16_t* xc; const float* br; const float* bi; const float* lam; float* EA; float* EH; float* sumA; float* sumH;
    __device__ __forceinline__ void operator()(const f32x4 (&acc)[2][2][4][2], const Unit& u, int wr, int wc, int fr, int fq) const {
        const int row0 = u.pm * 256 + wr * 64 + fr, ch0 = u.pn * 128 + wc * 32 + 8 * fq, lane = fr + 16 * fq, w = wr * 4 + wc;
        const int bb = u.pm >> 4, chunkb = (u.pm & 15) * 4 + wr;
        const size_t ebase = ((size_t)((u.pm * 8 + u.pn) * 8 + w)) * 2;
#pragma unroll
        for (int n = 0; n < 2; ++n) {
            float brv[4], biv[4], spl[4];
#pragma unroll
            for (int e = 0; e < 4; ++e) { brv[e] = br[ch0 + 4 * n + e]; biv[e] = bi[ch0 + 4 * n + e]; spl[e] = -8.f * log1pf(__expf(-lam[ch0 + 4 * n + e])); }
#pragma unroll
            for (int ai = 0; ai < 2; ++ai) {
                float cA[4] = {1.f, 1.f, 1.f, 1.f}, cH[4] = {0.f, 0.f, 0.f, 0.f};
#pragma unroll
                for (int m = 0; m < 4; ++m) {
                    const size_t ro = (size_t)(row0 + ai * 128 + m * 16) * 1024 + ch0 + 4 * n;
                    const u32x2 xx = *(const u32x2*)(xc + ro); const float xf[4] = {bflo(xx.x), bfhi(xx.x), bflo(xx.y), bfhi(xx.y)};
                    f32x4 av, hv;
#pragma unroll
                    for (int j = 0; j < 4; ++j) {
                        const float r = sigmoid_f(acc[ai][0][m][n][j] + brv[j]), ig = sigmoid_f(acc[ai][1][m][n][j] + biv[j]);
                        const float la = r * spl[j]; const float a = __expf(la); const float y2 = 2.f * la;
                        const float om = (y2 > -0.02f) ? -y2 * (1.f + y2 * (0.5f + y2 * (1.f / 6.f))) : (1.f - a * a);
                        float A = a, H = __builtin_amdgcn_sqrtf(om) * (ig * xf[j]);
                        LRU_SCAN_STEP(1); LRU_SCAN_STEP(2); LRU_SCAN_STEP(4); LRU_SCAN_STEP(8);
                        H = A * cH[j] + H; A = A * cA[j];
                        av[j] = A; hv[j] = H;
                        cA[j] = __shfl(A, (lane & 48) + 15); cH[j] = __shfl(H, (lane & 48) + 15); }
                    const size_t eo = ((((ebase + ai) * 4 + m) * 2 + n) * 64 + lane) * 4;
                    *(f32x4*)(EA + eo) = av; *(f32x4*)(EH + eo) = hv; }
                if (fr == 15) { const size_t so = ((size_t)(bb * 64 + chunkb + 2 * ai)) * 1024 + ch0 + 4 * n;
                    *(f32x4*)(sumA + so) = (f32x4){cA[0], cA[1], cA[2], cA[3]}; *(f32x4*)(sumH + so) = (f32x4){cH[0], cH[1], cH[2], cH[3]}; } } }
    }
};

struct EpiMerge {
    static constexpr bool PERM = true, INIT = false, KEEP = true;
    const bf16_t* gates; bf16_t* merged;
    __device__ __forceinline__ void apply(f32x4 (&acc)[2][2][4][2], const Unit& u, int wr, int wc, int fr, int fq) const {
        const int row0 = u.pm * 256 + wr * 64 + fr, col0 = u.pn * 256 + wc * 32 + 8 * fq, br = u.br;
        EPI_LOOP_AM { const int row = row0 + ai * 128 + m * 16;
#pragma unroll
            for (int bj = 0; bj < 2; ++bj) { const bf16_t* gp = gates + (size_t)row * 6144 + col0 + bj * 128;
                float sc[8];
                if (br < 2) { const u32x4 ga = *(const u32x4*)(gp + br * 2048), gb = *(const u32x4*)(gp + (br + 1) * 2048); float fa[8], fb[8]; unpack8(ga, fa); unpack8(gb, fb);
#pragma unroll
                    for (int e = 0; e < 8; ++e) sc[e] = fmaxf(fa[e], 1e-20f) * __builtin_amdgcn_rcpf(fmaxf(fb[e], 1e-20f));
                } else { const u32x4 ga = *(const u32x4*)(gp + 2 * 2048); float fa[8]; unpack8(ga, fa);
#pragma unroll
                    for (int e = 0; e < 8; ++e) sc[e] = fmaxf(fa[e], 1e-20f); }
#pragma unroll
                for (int j = 0; j < 4; ++j) { acc[ai][bj][m][0][j] *= sc[j]; acc[ai][bj][m][1][j] *= sc[4 + j]; }
                if (br == 2) *(u32x4*)(merged + (size_t)row * 2048 + col0 + bj * 128) = pack8(acc[ai][bj][m][0], acc[ai][bj][m][1]); } }
    }
    __device__ __forceinline__ void operator()(const f32x4 (&)[2][2][4][2], const Unit&, int, int, int, int) const {}
};

struct EpiResid {
    static constexpr bool PERM = true, INIT = true, KEEP = false;
    const float* rin; float* out; bf16_t* hb; float* part;
    __device__ __forceinline__ void init(f32x4 (&acc)[2][2][4][2], const Unit& u, int wr, int wc, int fr, int fq) const {
        const int row0 = u.pm * 256 + wr * 64 + fr, col0 = u.pn * 256 + wc * 32 + 8 * fq;
        EPI_LOOP_AM { const size_t ro = (size_t)(row0 + ai * 128 + m * 16) * 2048 + col0;
#pragma unroll
            for (int bj = 0; bj < 2; ++bj)
#pragma unroll
                for (int n = 0; n < 2; ++n) acc[ai][bj][m][n] = *(const f32x4*)(rin + ro + bj * 128 + n * 4); }
    }
    __device__ __forceinline__ void operator()(const f32x4 (&acc)[2][2][4][2], const Unit& u, int wr, int wc, int fr, int fq) const {
        const int row0 = u.pm * 256 + wr * 64 + fr, col0 = u.pn * 256 + wc * 32 + 8 * fq;
        EPI_LOOP_AM { const int row = row0 + ai * 128 + m * 16; const size_t ro = (size_t)row * 2048 + col0; float ss = 0.f;
#pragma unroll
            for (int bj = 0; bj < 2; ++bj) { const f32x4 v0 = acc[ai][bj][m][0], v1 = acc[ai][bj][m][1];
                *(f32x4*)(out + ro + bj * 128) = v0; *(f32x4*)(out + ro + bj * 128 + 4) = v1;
                *(u32x4*)(hb + ro + bj * 128) = pack8(v0, v1);
                ss += ((v0[0] * v0[0] + v0[1] * v0[1]) + (v0[2] * v0[2] + v0[3] * v0[3])) + ((v1[0] * v1[0] + v1[1] * v1[1]) + (v1[2] * v1[2] + v1[3] * v1[3])); }
            ss += __shfl_xor(ss, 16); ss += __shfl_xor(ss, 32);
            if (fq == 0) part[(size_t)row * 32 + u.pn * 4 + wc] = ss; }
    }
};

struct EpiUp {
    static constexpr bool PERM = true, INIT = false, KEEP = false;
    bf16_t* hdn; const float* rstd;
    __device__ __forceinline__ void operator()(const f32x4 (&acc)[2][2][4][2], const Unit& u, int wr, int wc, int fr, int fq) const {
        const int row0 = u.pm * 256 + wr * 64 + fr, col0 = u.pn * 256 + wc * 32 + 8 * fq;
        EPI_LOOP_AM { const int row = row0 + ai * 128 + m * 16; const size_t ro = (size_t)row * 8192 + col0; const float rs = rstd[row];
#pragma unroll
            for (int bj = 0; bj < 2; ++bj) { f32x4 v0 = acc[ai][bj][m][0], v1 = acc[ai][bj][m][1];
#pragma unroll
                for (int j = 0; j < 4; ++j) { const float a = fmaxf(v0[j] * rs, 0.f), b = fmaxf(v1[j] * rs, 0.f); v0[j] = a * a; v1[j] = b * b; }
                *(u32x4*)(hdn + ro + bj * 128) = pack8(v0, v1); } }
    }
};

__device__ __forceinline__ void transpose_item(const float* W, const float* kscale, int K, int N, bf16_t* WT, LAS float* scr, int item, int lane) {
    const int nblk = N / 64, kb = item / nblk, nb = item % nblk, k0 = 64 * kb, n0 = 64 * nb;
    const int n4 = lane & 15, ks = lane >> 4;
    f32x4 v[16];
#pragma unroll
    for (int i = 0; i < 16; ++i) { v[i] = __builtin_nontemporal_load((const f32x4*)(W + (size_t)(k0 + 4 * i + ks) * N + n0 + 4 * n4)); if (kscale) v[i] = v[i] * kscale[k0 + 4 * i + ks]; }
#pragma unroll
    for (int i = 0; i < 16; ++i) { LAS float* d = scr + (4 * i + ks) * 65 + 4 * n4; d[0] = v[i][0]; d[1] = v[i][1]; d[2] = v[i][2]; d[3] = v[i][3]; }
    asm volatile("s_waitcnt lgkmcnt(0)" ::: "memory"); __builtin_amdgcn_wave_barrier();
    const int c = lane & 7;
#pragma unroll
    for (int j = 0; j < 8; ++j) { const int n = (lane >> 3) + 8 * j; const LAS float* sp = scr + (8 * c) * 65 + n;
        u32x4 o; o.x = cvt_pk_bf16(sp[0 * 65], sp[1 * 65]); o.y = cvt_pk_bf16(sp[2 * 65], sp[3 * 65]); o.z = cvt_pk_bf16(sp[4 * 65], sp[5 * 65]); o.w = cvt_pk_bf16(sp[6 * 65], sp[7 * 65]);
        *(u32x4*)(WT + (size_t)(n0 + n) * K + k0 + 8 * c) = o; }
    asm volatile("s_waitcnt lgkmcnt(0)" ::: "memory"); __builtin_amdgcn_wave_barrier();
}
__device__ __forceinline__ void transpose_matrix(const float* W, int K, int N, bf16_t* WT, LAS float* scr, int gw, int NGW, int lane, const float* kscale = nullptr) {
    const int nitems = (K / 64) * (N / 64);
    for (int it = gw; it < nitems; it += NGW) transpose_item(W, kscale, K, N, WT, scr, it, lane);
}

template <bool F32OUT>
__device__ __forceinline__ void rmsnorm_rows(const float* src, const float* g, void* dst, int gw, int NGW, int lane) {
    for (int row = gw; row < T_TOK; row += NGW) {
        const f32x4* xr = (const f32x4*)(src + (size_t)row * 2048) + lane;
        f32x4 v[8]; float ss = 0.f;
#pragma unroll
        for (int j = 0; j < 8; ++j) { v[j] = xr[64 * j]; ss += (v[j][0] * v[j][0] + v[j][1] * v[j][1]) + (v[j][2] * v[j][2] + v[j][3] * v[j][3]); }
        const float rstd = 1.f / sqrtf(wave_sum(ss) * (1.f / 2048.f) + EPSN);
#pragma unroll
        for (int j = 0; j < 8; ++j) { const f32x4 gg = *((const f32x4*)g + lane + 64 * j); f32x4 o;
#pragma unroll
            for (int e = 0; e < 4; ++e) o[e] = v[j][e] * rstd * gg[e];
            if (F32OUT) *((f32x4*)((float*)dst + (size_t)row * 2048) + lane + 64 * j) = o;
            else { u32x2 p; p.x = cvt_pk_bf16(o[0], o[1]); p.y = cvt_pk_bf16(o[2], o[3]); *((u32x2*)((bf16_t*)dst + (size_t)row * 2048) + lane + 64 * j) = p; } }
    }
}

__device__ __forceinline__ void x_prep_rows(const float* src, bf16_t* hb, float* rstd, int gw, int NGW, int lane) {
    for (int row = gw; row < T_TOK; row += NGW) {
        const f32x4* xr = (const f32x4*)(src + (size_t)row * 2048) + lane;
        f32x4 v[8]; float ss = 0.f;
#pragma unroll
        for (int j = 0; j < 8; ++j) { v[j] = xr[64 * j]; ss += (v[j][0] * v[j][0] + v[j][1] * v[j][1]) + (v[j][2] * v[j][2] + v[j][3] * v[j][3]); }
        ss = wave_sum(ss);
        if (lane == 0) rstd[row] = 1.f / sqrtf(ss * (1.f / 2048.f) + EPSN);
#pragma unroll
        for (int j = 0; j < 8; ++j) { u32x2 p; p.x = cvt_pk_bf16(v[j][0], v[j][1]); p.y = cvt_pk_bf16(v[j][2], v[j][3]); *((u32x2*)(hb + (size_t)row * 2048) + lane + 64 * j) = p; }
    }
}
__device__ __forceinline__ void rstd_rows(const float* part, float* rstd, int gt, int NGT) {
    for (int row = gt; row < T_TOK; row += NGT) { const f32x4* p = (const f32x4*)(part + (size_t)row * 32); float ss = 0.f;
#pragma unroll
        for (int j = 0; j < 8; ++j) { const f32x4 q = p[j]; ss += (q[0] + q[1]) + (q[2] + q[3]); }
        rstd[row] = 1.f / sqrtf(ss * (1.f / 2048.f) + EPSN); }
}

__device__ __forceinline__ void s5_prep_item(int g, int q, const float* lam_re, const float* lam_im, const float* log_dt, const float* b_re, const float* b_im,
                                             const float* c_re, const float* c_im, float* ptab, float* ktau, bf16_t* M2, LAS float* sm, int tid) {
    LAS float* Pr = sm;
    LAS float* Pi = sm + 1088;
    LAS float* Br = sm + 2176;
    LAS float* Bi = sm + 3200;
    LAS float* Cr = sm + 4224;
    LAS float* Ci = sm + 5264;
    const double dt = (double)expf(log_dt[g]);
    for (int idx = tid; idx < 1088; idx += 512) { const int p = idx / 17, tau = idx % 17;
        const double lr = lam_re[g * 64 + p], li = lam_im[g * 64 + p];
        const float mag = expf((float)(lr * dt * tau)); double ang = li * dt * tau; ang -= 6.283185307179586 * rint(ang * 0.15915494309189535);
        const float fa = (float)ang; Pr[idx] = mag * cosf(fa); Pi[idx] = mag * sinf(fa); }
    for (int idx = tid; idx < 1024; idx += 512) { const int c = idx >> 6, p = idx & 63; Cr[c * 65 + p] = c_re[(g * 16 + c) * 64 + p]; Ci[c * 65 + p] = c_im[(g * 16 + c) * 64 + p]; }
    __syncthreads();
    for (int idx = tid; idx < 1024; idx += 512) { const int p = idx >> 4;
        const float lr = lam_re[g * 64 + p], li = lam_im[g * 64 + p];
        const float xr = Pr[p * 17 + 1] - 1.f, xi = Pi[p * 17 + 1]; const float den = 1.f / (lr * lr + li * li);
        const float fr_ = (xr * lr + xi * li) * den, fi_ = (xi * lr - xr * li) * den;
        const float br_ = b_re[(size_t)g * 1024 + idx], bi_ = b_im[(size_t)g * 1024 + idx];
        Br[idx] = fr_ * br_ - fi_ * bi_; Bi[idx] = fr_ * bi_ + fi_ * br_; }
    __syncthreads();
    if (q == 0) for (int idx = tid; idx < 1088; idx += 512) { ptab[((size_t)g * 1088 + idx) * 2] = Pr[idx]; ptab[((size_t)g * 1088 + idx) * 2 + 1] = Pi[idx]; }
    { const int nl = tid >> 3, n = 64 * q + nl, kb = (tid & 7) * 32; bf16_t* dst = M2 + ((size_t)(g * 256 + n)) * 256 + kb;
#pragma unroll
        for (int v = 0; v < 4; ++v) { float f[8];
#pragma unroll
            for (int e = 0; e < 8; ++e) { const int k = kb + v * 8 + e, s = k >> 4, c = k & 15; float val = 0.f;
                if (q < 2) { const int p = nl; const float pr = Pr[p * 17 + 15 - s], pi = Pi[p * 17 + 15 - s], b0 = Br[p * 16 + c], b1 = Bi[p * 16 + c];
                    val = (q == 0) ? (pr * b0 - pi * b1) : (pr * b1 + pi * b0); }
                f[e] = val; }
            u32x4 o; o.x = cvt_pk_bf16(f[0], f[1]); o.y = cvt_pk_bf16(f[2], f[3]); o.z = cvt_pk_bf16(f[4], f[5]); o.w = cvt_pk_bf16(f[6], f[7]);
            *(u32x4*)(dst + v * 8) = o; } }
#pragma unroll
    for (int r = 0; r < 2; ++r) { const int o = tid + 512 * r, tau = 4 * q + (o >> 8), cp = (o >> 4) & 15, c = o & 15; float sum = 0.f;
        for (int p = 0; p < 64; ++p) { const float cr = Cr[cp * 65 + p], ci = Ci[cp * 65 + p], pr = Pr[p * 17 + tau], pi = Pi[p * 17 + tau];
            const float gr = cr * pr - ci * pi, gi = cr * pi + ci * pr; sum += gr * Br[p * 16 + c] - gi * Bi[p * 16 + c]; }
        ktau[(size_t)g * 4096 + tau * 256 + cp * 16 + c] = sum; }
    __syncthreads();
}

__device__ __forceinline__ void s5_fill_m13(const float* ktau, const float* ptab, const float* c_re, const float* c_im, bf16_t* M13, int gt, int NGT) {
    for (int it = gt; it < 64 * 256 * 48; it += NGT) { const int k8 = it % 48, n = (it / 48) & 255, g = it / (48 * 256); const int t = n >> 4, cp = n & 15; float f[8];
        if (k8 < 32) { const int s = k8 >> 1, c0 = (k8 & 1) * 8;
            if (s <= t) { const float* kp = ktau + (size_t)g * 4096 + (t - s) * 256 + cp * 16 + c0;
#pragma unroll
                for (int e = 0; e < 8; ++e) f[e] = kp[e]; }
            else {
#pragma unroll
                for (int e = 0; e < 8; ++e) f[e] = 0.f; }
        } else { const int kk = (k8 - 32) * 8, im = kk >> 6, p0 = kk & 63;
#pragma unroll
            for (int e = 0; e < 8; ++e) { const int p = p0 + e; const float cr = c_re[(g * 16 + cp) * 64 + p], ci = c_im[(g * 16 + cp) * 64 + p];
                const float pr = ptab[((size_t)g * 1088 + p * 17 + t + 1) * 2], pi = ptab[((size_t)g * 1088 + p * 17 + t + 1) * 2 + 1];
                f[e] = im ? -(cr * pi + ci * pr) : (cr * pr - ci * pi); } }
        u32x4 o; o.x = cvt_pk_bf16(f[0], f[1]); o.y = cvt_pk_bf16(f[2], f[3]); o.z = cvt_pk_bf16(f[4], f[5]); o.w = cvt_pk_bf16(f[6], f[7]);
        *(u32x4*)(M13 + ((size_t)(g * 256 + n)) * 384 + k8 * 8) = o; }
}

__device__ __forceinline__ void lru_fill_w(const float* w_r, const float* w_i, bf16_t* WL, int gt, int NGT) {
    for (int it = gt; it < 2048 * 32; it += NGT) { const int k8 = it & 31, row = it >> 5; const int pn = row >> 8, which = (row >> 7) & 1, j = row & 127;
        const int ch = pn * 128 + j, nblk = ch >> 6, kk = ch & 63, kin0 = (pn >> 1) * 256 + k8 * 8; float f[8];
        if ((kin0 >> 6) == nblk) { const float* w = (which ? w_i : w_r) + ((size_t)(nblk * 64 + (kin0 & 63))) * 64 + kk;
#pragma unroll
            for (int e = 0; e < 8; ++e) f[e] = w[e * 64]; }
        else {
#pragma unroll
            for (int e = 0; e < 8; ++e) f[e] = 0.f; }
        u32x4 o; o.x = cvt_pk_bf16(f[0], f[1]); o.y = cvt_pk_bf16(f[2], f[3]); o.z = cvt_pk_bf16(f[4], f[5]); o.w = cvt_pk_bf16(f[6], f[7]);
        *(u32x4*)(WL + (size_t)row * 256 + k8 * 8) = o; }
}

__device__ __forceinline__ void lru_conv(const bf16_t* ulru, const float* cw, const float* cb, bf16_t* xc, int gt, int NGT) {
    for (int it = gt; it < (T_TOK / 16) * 128; it += NGT) { const int c8 = it & 127, seg = it >> 7, tok0 = seg * 16, ch = c8 * 8;
        float w[4][8], bs[8];
#pragma unroll
        for (int e = 0; e < 8; ++e) bs[e] = cb[ch + e];
#pragma unroll
        for (int k = 0; k < 4; ++k)
#pragma unroll
            for (int e = 0; e < 8; ++e) w[k][e] = cw[k * 1024 + ch + e];
        float x0[8], x1[8], x2[8];
        const bool head = (tok0 & 4095) == 0;
        { u32x4 z = {0u, 0u, 0u, 0u};
          const u32x4 a0 = head ? z : *(const u32x4*)(ulru + (size_t)(tok0 - 3) * 1024 + ch), a1 = head ? z : *(const u32x4*)(ulru + (size_t)(tok0 - 2) * 1024 + ch), a2 = head ? z : *(const u32x4*)(ulru + (size_t)(tok0 - 1) * 1024 + ch);
          unpack8(a0, x0); unpack8(a1, x1); unpack8(a2, x2); }
        u32x4 cur[16];
#pragma unroll
        for (int t = 0; t < 16; ++t) cur[t] = *(const u32x4*)(ulru + (size_t)(tok0 + t) * 1024 + ch);
#pragma unroll
        for (int t = 0; t < 16; ++t) { float x3[8]; unpack8(cur[t], x3); float a[8];
#pragma unroll
            for (int e = 0; e < 8; ++e) a[e] = bs[e] + w[0][e] * x0[e] + w[1][e] * x1[e] + w[2][e] * x2[e] + w[3][e] * x3[e];
            u32x4 o; o.x = cvt_pk_bf16(a[0], a[1]); o.y = cvt_pk_bf16(a[2], a[3]); o.z = cvt_pk_bf16(a[4], a[5]); o.w = cvt_pk_bf16(a[6], a[7]);
            *(u32x4*)(xc + (size_t)(tok0 + t) * 1024 + ch) = o;
#pragma unroll
            for (int e = 0; e < 8; ++e) { x0[e] = x1[e]; x1[e] = x2[e]; x2[e] = x3[e]; } }
    }
}

__device__ __forceinline__ void s5_panel_scan(const float* send, const float* ptab, bf16_t* A5, LAS unsigned char* lds, int bid, int G, int tid) {
    const int lane = tid & 63, wave = __builtin_amdgcn_readfirstlane(tid >> 6);
    LAS float* S = (LAS float*)lds;
    LAS float* E = (LAS float*)(lds + 131072);
    for (int pm = bid; pm < 256; pm += G) { const int g = pm >> 2;
        const f32x4* src = (const f32x4*)(send + (size_t)pm * 256 * 128);
#pragma unroll
        for (int i = 0; i < 16; ++i) { const int idx = i * 512 + tid; *(LAS f32x4*)(S + idx * 4) = src[idx]; }
        const float lr = ptab[((size_t)g * 1088 + lane * 17 + 16) * 2], li = ptab[((size_t)g * 1088 + lane * 17 + 16) * 2 + 1];
        __syncthreads();
        float hr = 0.f, hi = 0.f;
        for (int j = 0; j < 32; ++j) { const int c = wave * 32 + j; const float sr = S[c * 128 + lane], si = S[c * 128 + 64 + lane];
            S[c * 128 + lane] = hr; S[c * 128 + 64 + lane] = hi;
            const float nr = lr * hr - li * hi + sr, ni = lr * hi + li * hr + si; hr = nr; hi = ni; }
        E[wave * 128 + lane] = hr; E[wave * 128 + 64 + lane] = hi;
        __syncthreads();
        float pr = lr, pi = li;
#pragma unroll
        for (int k = 0; k < 5; ++k) { const float t0 = pr * pr - pi * pi, t1 = 2.f * pr * pi; pr = t0; pi = t1; }
        float cr = 0.f, ci = 0.f;
        for (int v = 0; v < wave; ++v) { const float er = E[v * 128 + lane], ei = E[v * 128 + 64 + lane]; const float nr = pr * cr - pi * ci + er, ni = pr * ci + pi * cr + ei; cr = nr; ci = ni; }
        float wr_ = 1.f, wi_ = 0.f;
        for (int j = 0; j < 32; ++j) { const int c = wave * 32 + j;
            const float sr = S[c * 128 + lane] + (wr_ * cr - wi_ * ci), si = S[c * 128 + 64 + lane] + (wr_ * ci + wi_ * cr);
            const size_t R = (size_t)pm * 256 + c; A5[R * 384 + 256 + lane] = f2bf(sr); A5[R * 384 + 320 + lane] = f2bf(si);
            const float nr = lr * wr_ - li * wi_, ni = lr * wi_ + li * wr_; wr_ = nr; wi_ = ni; }
        __syncthreads();
    }
}

__device__ __forceinline__ void lru_fixup(const float* EA, const float* EH, const float* sumA, const float* sumH, bf16_t* ylru, int gw, int NGW, int lane) {
    const int fr = lane & 15, fq = lane >> 4;
    for (int id = gw; id < 8192; id += NGW) { const int ai = id & 1, w = (id >> 1) & 7, pn = (id >> 4) & 7, pm = id >> 7, wr = w >> 2, wc = w & 3;
        const int ch0 = pn * 128 + wc * 32 + 8 * fq, bb = pm >> 4, chunk = (pm & 15) * 4 + 2 * ai + wr;
        const f32x4* ea = (const f32x4*)EA + (size_t)id * 512 + lane; const f32x4* eh = (const f32x4*)EH + (size_t)id * 512 + lane;
        f32x4 va[8], vh[8];
#pragma unroll
        for (int q = 0; q < 8; ++q) { va[q] = ea[q * 64]; vh[q] = eh[q * 64]; }
        f32x4 cc[2];
#pragma unroll
        for (int n = 0; n < 2; ++n) { f32x4 sa[4], sh[4];
#pragma unroll
            for (int i = 0; i < 4; ++i) { const size_t o = (size_t)(bb * 64 + 4 * fr + i) * 1024 + ch0 + 4 * n; sa[i] = *(const f32x4*)(sumA + o); sh[i] = *(const f32x4*)(sumH + o); }
#pragma unroll
            for (int j = 0; j < 4; ++j) { float A = 1.f, H = 0.f;
#pragma unroll
                for (int i = 0; i < 4; ++i) { const bool ok = (4 * fr + i) < chunk; const float a = ok ? sa[i][j] : 1.f, g = ok ? sh[i][j] : 0.f; H = a * H + g; A = a * A; }
                LRU_SCAN_STEP(1); LRU_SCAN_STEP(2); LRU_SCAN_STEP(4); LRU_SCAN_STEP(8);
                cc[n][j] = __shfl(H, (lane & 48) + 15); } }
#pragma unroll
        for (int m = 0; m < 4; ++m) { const f32x4 h0 = vh[2 * m] + va[2 * m] * cc[0], h1 = vh[2 * m + 1] + va[2 * m + 1] * cc[1];
            *(u32x4*)(ylru + (size_t)(pm * 256 + ai * 128 + wr * 64 + m * 16 + fr) * 1024 + ch0) = pack8(h0, h1); }
    }
}

#define MFMA32(a, b, c) __builtin_amdgcn_mfma_f32_32x32x16_bf16((a), (b), (c), 0, 0, 0)
__device__ __forceinline__ void attn_task(const bf16_t* Q, const bf16_t* K, const bf16_t* V, bf16_t* O, int b, int h, int qt, LAS unsigned char* vlds, int lane) {
    const int l32 = lane & 31, hh = lane >> 5;
    const size_t base = (size_t)b * 4096;
    const int q0 = qt * 32, colh = h * 128, qidx = q0 + l32;
    bf16x8 qf[8];
    { const bf16_t* qp = Q + (base + q0 + l32) * 1024 + colh + 8 * hh;
#pragma unroll
        for (int kk = 0; kk < 8; ++kk) qf[kk] = *(const bf16x8*)(qp + 16 * kk); }
    f32x16 o[4];
#pragma unroll
    for (int d = 0; d < 4; ++d)
#pragma unroll
        for (int r = 0; r < 16; ++r) o[d][r] = 0.f;
    float R = 0.f;
    bf16x8 kf[8];
    { const bf16_t* kp = K + (base + q0 + l32) * 1024 + colh + 8 * hh;
#pragma unroll
        for (int kk = 0; kk < 8; ++kk) kf[kk] = *(const bf16x8*)(kp + 16 * kk); }
    int vb = 0;
#pragma unroll
    for (int i = 0; i < 8; ++i) { const int idx = i * 64 + lane, row = idx >> 4, ck = idx & 15;
        const u32x4 vv = *(const u32x4*)(V + (base + q0 + row) * 1024 + colh + ck * 8);
        *(LAS u32x4*)(vlds + row * 256 + ck * 16) = vv; }
    for (int kt = qt; kt >= 0; --kt) {
        const int k0 = kt * 32;
        u32x4 vn[8];
        if (kt > 0) {
#pragma unroll
            for (int i = 0; i < 8; ++i) { const int idx = i * 64 + lane, row = idx >> 4, ck = idx & 15; vn[i] = *(const u32x4*)(V + (base + k0 - 32 + row) * 1024 + colh + ck * 8); } }
        f32x16 S;
#pragma unroll
        for (int r = 0; r < 16; ++r) S[r] = 0.f;
#pragma unroll
        for (int kk = 0; kk < 8; ++kk) S = MFMA32(kf[kk], qf[kk], S);
        if (kt > 0) { const bf16_t* kp = K + (base + k0 - 32 + l32) * 1024 + colh + 8 * hh;
#pragma unroll
            for (int kk = 0; kk < 8; ++kk) kf[kk] = *(const bf16x8*)(kp + 16 * kk); }
        const bool diag = (kt == qt);
        float lk[16], ls[16];
#pragma unroll
        for (int r = 0; r < 16; ++r) { const float z = S[r] * 0.08838834764831845f; const float sp = fmaxf(z, 0.f) + __logf(1.f + __expf(-fabsf(z)));
            const int kidx = k0 + (r & 3) + 8 * (r >> 2) + 4 * hh; const bool valid = (!diag) || (kidx < qidx);
            lk[r] = valid ? -sp : 0.f; ls[r] = valid ? (z - sp) : -1e30f; }
        float gs[4], og[4], tail[4];
#pragma unroll
        for (int g = 0; g < 4; ++g) { gs[g] = (lk[4 * g] + lk[4 * g + 1]) + (lk[4 * g + 2] + lk[4 * g + 3]); og[g] = __shfl_xor(gs[g], 32); }
        float accs = 0.f;
#pragma unroll
        for (int g = 3; g >= 0; --g) { tail[g] = accs + (hh == 0 ? og[g] : 0.f); accs += gs[g] + og[g]; }
        float w[16];
#pragma unroll
        for (int g = 0; g < 4; ++g) { const float bs = R + tail[g]; const float i2 = lk[4 * g + 3], i1 = i2 + lk[4 * g + 2], i0 = i1 + lk[4 * g + 1];
            w[4 * g + 3] = __expf(ls[4 * g + 3] + bs); w[4 * g + 2] = __expf(ls[4 * g + 2] + bs + i2);
            w[4 * g + 1] = __expf(ls[4 * g + 1] + bs + i1); w[4 * g] = __expf(ls[4 * g] + bs + i0); }
        R += accs;
        bf16x8 wf[2];
#pragma unroll
        for (int s = 0; s < 2; ++s) { u32x4 p; p.x = cvt_pk_bf16(w[8 * s], w[8 * s + 1]); p.y = cvt_pk_bf16(w[8 * s + 2], w[8 * s + 3]); p.z = cvt_pk_bf16(w[8 * s + 4], w[8 * s + 5]); p.w = cvt_pk_bf16(w[8 * s + 6], w[8 * s + 7]);
            wf[s] = __builtin_bit_cast(bf16x8, p); }
        asm volatile("s_waitcnt lgkmcnt(0)" ::: "memory"); __builtin_amdgcn_wave_barrier();
#pragma unroll
        for (int db = 0; db < 4; ++db)
#pragma unroll
            for (int s = 0; s < 2; ++s) { bf16x8 vf;
#pragma unroll
                for (int j = 0; j < 8; ++j) { const int row = 16 * s + 8 * (j >> 2) + 4 * hh + (j & 3); vf[j] = *(const LAS short*)(vlds + vb * 8192 + row * 256 + (32 * db + l32) * 2); }
                o[db] = MFMA32(vf, wf[s], o[db]); }
        asm volatile("s_waitcnt lgkmcnt(0)" ::: "memory"); __builtin_amdgcn_wave_barrier();
        if (__ballot(R > -105.f) == 0ull) break;
        if (kt > 0) {
#pragma unroll
            for (int i = 0; i < 8; ++i) { const int idx = i * 64 + lane, row = idx >> 4, ck = idx & 15; *(LAS u32x4*)(vlds + (vb ^ 1) * 8192 + row * 256 + ck * 16) = vn[i]; } }
        vb ^= 1;
    }
    bf16_t* op = O + (base + q0 + l32) * 1024 + colh + 4 * hh;
#pragma unroll
    for (int db = 0; db < 4; ++db)
#pragma unroll
        for (int g4 = 0; g4 < 4; ++g4) { u32x2 p; p.x = cvt_pk_bf16(o[db][4 * g4], o[db][4 * g4 + 1]); p.y = cvt_pk_bf16(o[db][4 * g4 + 2], o[db][4 * g4 + 3]);
            *(u32x2*)(op + 32 * db + 8 * g4) = p; }
}

#define XB_TMO      128
#define XB_XCNT(j)  (256  + 64 * (j))
#define XB_XSUB(j)  (1280 + 64 * (j))
#define XB_XGEN(j)  (2304 + 64 * (j))
#define XB_TOP      3328
#define XB_TOPGEN   3392
#define XCD_BAR_WORDS 3456
#define XB_SPIN_CAP (1u << 20)
__device__ __forceinline__ unsigned xb_ld(unsigned* p)              { return __hip_atomic_load(p, __ATOMIC_RELAXED, __HIP_MEMORY_SCOPE_AGENT); }
__device__ __forceinline__ unsigned xb_add(unsigned* p, unsigned v) { return __hip_atomic_fetch_add(p, v, __ATOMIC_RELAXED, __HIP_MEMORY_SCOPE_AGENT); }
__device__ __forceinline__ unsigned xb_xcc_id() { return (unsigned)__builtin_amdgcn_s_getreg((3 << 11) | 20) & 0xFu; }
#define XB_SPIN(cond, bar) do { unsigned _sp = 0; while (cond) { __builtin_amdgcn_s_sleep(1); \
    if ((++_sp & 255u) == 0u) { if (xb_ld(&(bar)[XB_TMO])) break; if (_sp > XB_SPIN_CAP) { atomicAdd(&(bar)[XB_TMO], 1u); break; } } } } while (0)
struct XcdBarrier { unsigned* bar; unsigned x; volatile LAS unsigned* st; };
__device__ __forceinline__ XcdBarrier xcd_barrier_post(unsigned* bar, volatile LAS unsigned* st) {
    XcdBarrier b; b.bar = bar; b.x = xb_xcc_id(); b.st = st;
    if (threadIdx.x == 0) (void)xb_add(&bar[XB_XCNT(b.x)], 1u);
    return b;
}
__device__ __forceinline__ void xcd_barrier_complete(unsigned* bar, unsigned x, unsigned& nloc, unsigned& nx) {
    const unsigned G = gridDim.x * gridDim.y * gridDim.z;
    unsigned sum, cnt, mine, sp = 0u;
    for (;;) {
        sum = 0u; cnt = 0u; mine = 0u;
#pragma unroll
        for (unsigned j = 0; j < 16; ++j) { const unsigned c = xb_ld(&bar[XB_XCNT(j)]); sum += c; cnt += (c > 0u) ? 1u : 0u; mine = (j == x) ? c : mine; }
        if (sum == G) break;
        __builtin_amdgcn_s_sleep(1);
        if ((++sp & 255u) == 0u) { if (xb_ld(&bar[XB_TMO])) break; if (sp > XB_SPIN_CAP) { atomicAdd(&bar[XB_TMO], 1u); break; } }
    }
    nloc = mine > 0u ? mine : 1u; nx = cnt > 0u ? cnt : 1u;
}
__device__ __forceinline__ void xcd_barrier(const XcdBarrier& b) {
    asm volatile("s_waitcnt vmcnt(0)" ::: "memory");
    __syncthreads();
    if (threadIdx.x == 0) {
        unsigned* bar = b.bar;
        __builtin_amdgcn_s_waitcnt(0);
        unsigned nloc = b.st[0], nx = b.st[1];
        if (nloc == 0u) { xcd_barrier_complete(bar, b.x, nloc, nx); b.st[0] = nloc; b.st[1] = nx; }
        const unsigned old = xb_add(&bar[XB_XSUB(b.x)], 1u);
        const unsigned gen = old / nloc;
        if (old + 1u == (gen + 1u) * nloc) {
            __builtin_amdgcn_fence(__ATOMIC_RELEASE, "agent");
            asm volatile("s_waitcnt vmcnt(0)" ::: "memory");
            const unsigned og = xb_add(&bar[XB_TOP], 1u);
            const unsigned tg = og / nx;
            if (og + 1u == (tg + 1u) * nx) xb_add(&bar[XB_TOPGEN], 1u);
            else XB_SPIN(xb_ld(&bar[XB_TOPGEN]) == tg, bar);
            __builtin_amdgcn_fence(__ATOMIC_ACQUIRE, "agent");
            xb_add(&bar[XB_XGEN(b.x)], 1u);
            asm volatile("s_waitcnt vmcnt(0)" ::: "memory");
        } else {
            XB_SPIN(xb_ld(&bar[XB_XGEN(b.x)]) == gen, bar);
            __builtin_amdgcn_fence(__ATOMIC_ACQUIRE, "agent");
            asm volatile("s_waitcnt vmcnt(0)" ::: "memory");
        }
    }
    __syncthreads();
}

struct Params { const float* in[29]; float* out; unsigned char* ws; };
constexpr int LDS_ST_OFF = 135168;
constexpr int LDS_BYTES = 135168 + 64;

__device__ __forceinline__ unsigned char* opaque_p(unsigned char* p) { asm volatile("" : "+s"(p)); return p; }
__device__ __forceinline__ int opaque_s(int v) { asm volatile("" : "+s"(v)); return v; }
#define PH_BEGIN { const int tid = opaque((int)threadIdx.x), lane = tid & 63, wave = __builtin_amdgcn_readfirstlane(tid >> 6); \
    const int G = opaque_s((int)gridDim.x), bid = opaque_s((int)blockIdx.x); const int gw = bid * 8 + wave, NGW = G * 8, gt = bid * 512 + tid, NGT = G * 512; \
    unsigned char* ws = opaque_p(P.ws); LAS unsigned char* lds = (LAS unsigned char*)shm; LAS float* scr = (LAS float*)(lds + wave * 16640); \
    (void)lane; (void)gw; (void)NGW; (void)gt; (void)NGT; (void)ws; (void)scr; (void)G; (void)bid;
#define PH_END }
#define WS_BF(off) ((bf16_t*)(ws + (off)))
#define WS_F(off) ((float*)(ws + (off)))

__global__ void __launch_bounds__(512, 2) fwd_kernel(Params P) {
    extern __shared__ __attribute__((aligned(16))) unsigned char shm[];
    cg::grid_group grid = cg::this_grid();
    volatile LAS unsigned* xst = (volatile LAS unsigned*)((LAS unsigned char*)shm + LDS_ST_OFF);
    if (threadIdx.x == 0) { xst[0] = 0u; xst[1] = 0u; }
    __syncthreads();
    const XcdBarrier xb = xcd_barrier_post((unsigned*)(P.ws + OFF_BAR), xst);
#define GSYNC_CG() do { asm volatile("s_waitcnt vmcnt(0) lgkmcnt(0)" ::: "memory"); __threadfence(); asm volatile("s_waitcnt vmcnt(0)" ::: "memory"); grid.sync(); \
    __builtin_amdgcn_fence(__ATOMIC_ACQUIRE, "agent"); asm volatile("s_waitcnt vmcnt(0)" ::: "memory"); } while (0)
#define GSYNC() xcd_barrier(xb)
    grid.sync();
    float* hres = P.out;

#pragma unroll 1
    for (int l = 0; l < 2; ++l) {
        const float* hin = (l == 0) ? P.in[0] : hres;
        PH_BEGIN
        for (int it = bid; it < 256; it += G)
            s5_prep_item(it >> 2, it & 3, P.in[4] + l * 4096, P.in[5] + l * 4096, P.in[6] + l * 64, P.in[7] + (size_t)l * 65536, P.in[8] + (size_t)l * 65536,
                         P.in[9] + (size_t)l * 65536, P.in[10] + (size_t)l * 65536, WS_F(OFF_PTAB), WS_F(OFF_KTAU), WS_BF(OFF_M2), (LAS float*)lds, tid);
        PH_END
        PH_BEGIN transpose_matrix(P.in[2] + (size_t)l * 2048 * INC, 2048, INC, WS_BF(OFF_WIN), scr, gw, NGW, lane, P.in[1] + l * 2048); PH_END
        PH_BEGIN transpose_matrix(P.in[12] + (size_t)l * 1024 * 1024, 1024, 1024, WS_BF(OFF_WGLU), scr, gw, NGW, lane); PH_END
        PH_BEGIN transpose_matrix(P.in[21] + (size_t)l * 1024 * 2048, 1024, 2048, WS_BF(OFF_WBR), scr, gw, NGW, lane); PH_END
        PH_BEGIN transpose_matrix(P.in[22] + (size_t)l * 1024 * 2048, 1024, 2048, WS_BF(OFF_WBR) + (size_t)2048 * 1024, scr, gw, NGW, lane); PH_END
        PH_BEGIN transpose_matrix(P.in[23] + (size_t)l * 1024 * 2048, 1024, 2048, WS_BF(OFF_WBR) + (size_t)2 * 2048 * 1024, scr, gw, NGW, lane); PH_END
        PH_BEGIN transpose_matrix(P.in[24] + (size_t)l * 2048 * 2048, 2048, 2048, WS_BF(OFF_WOUT), scr, gw, NGW, lane); PH_END
        PH_BEGIN lru_fill_w(P.in[16] + (size_t)l * 65536, P.in[18] + (size_t)l * 65536, WS_BF(OFF_WLRU), gt, NGT); PH_END
        if (l == 0) { PH_BEGIN x_prep_rows(hin, WS_BF(OFF_X2), WS_F(OFF_RSTD), gw, NGW, lane); PH_END }
        else { PH_BEGIN rstd_rows(WS_F(OFF_PART), WS_F(OFF_RSTD), gt, NGT); PH_END }
        GSYNC();
        PH_BEGIN pg8::Gemm g{WS_BF(OFF_X2), WS_BF(OFF_WIN), T_TOK, INC, 2048, 2048, 2048}; pg8::StaticOrder S; S.init(T_TOK, INC, G, bid);
          EpiInProj E{WS_BF(OFF_A5), WS_BF(OFF_ULRU), WS_BF(OFF_R3), WS_BF(OFF_GATES), P.in[3] + l * 6144, WS_F(OFF_RSTD)}; pg8::gemm_phase(lds, g, S, E); PH_END
        GSYNC();
        PH_BEGIN pg8::Gemm g{WS_BF(OFF_A5), WS_BF(OFF_M2), 65536, 16384, 256, 384, 256}; pg8::BatchOrder S; S.init(G, bid); EpiS5A E{WS_F(OFF_SEND)}; pg8::gemm_phase(lds, g, S, E); PH_END
        PH_BEGIN s5_panel_scan(WS_F(OFF_SEND), WS_F(OFF_PTAB), WS_BF(OFF_A5), lds, (G % 8 == 0) ? (bid % 8) * (G / 8) + bid / 8 : bid, G, tid); PH_END
        PH_BEGIN lru_conv(WS_BF(OFF_ULRU), P.in[14] + l * 4096, P.in[15] + l * 1024, WS_BF(OFF_XC), gt, NGT); PH_END
        PH_BEGIN s5_fill_m13(WS_F(OFF_KTAU), WS_F(OFF_PTAB), P.in[9] + (size_t)l * 65536, P.in[10] + (size_t)l * 65536, WS_BF(OFF_M13), gt, NGT); PH_END
        PH_BEGIN
        for (int id = gw; id < 4096; id += NGW) { const int bh = id >> 7, qt = id & 127;
            attn_task(WS_BF(OFF_R3), WS_BF(OFF_R3) + (size_t)T_TOK * 1024, WS_BF(OFF_R3) + (size_t)2 * T_TOK * 1024, WS_BF(OFF_YATT), bh >> 3, bh & 7, qt, lds + wave * 16384, lane); }
        PH_END
        GSYNC();
        PH_BEGIN pg8::Gemm g{WS_BF(OFF_A5), WS_BF(OFF_M13), 65536, 16384, 384, 384, 384}; pg8::BatchOrder S; S.init(G, bid); EpiS5B E{WS_BF(OFF_A5), P.in[11] + l * 1024, WS_BF(OFF_YPRE)}; pg8::gemm_phase(lds, g, S, E); PH_END
        PH_BEGIN pg8::Gemm g{WS_BF(OFF_XC), WS_BF(OFF_WLRU), T_TOK, 2048, 256, 1024, 256, 256}; pg8::StaticOrder S; S.init(T_TOK, 2048, G, bid);
          EpiLruGate E{WS_BF(OFF_XC), P.in[17] + l * 1024, P.in[19] + l * 1024, P.in[20] + l * 1024, WS_F(OFF_R3), WS_F(OFF_R3 + 64 * MiB), WS_F(OFF_SUMA), WS_F(OFF_SUMH)}; pg8::gemm_phase(lds, g, S, E); PH_END
        GSYNC();
        PH_BEGIN pg8::Gemm g{WS_BF(OFF_YPRE), WS_BF(OFF_WGLU), T_TOK, 1024, 1024, 1024, 1024}; pg8::StaticOrder S; S.init(T_TOK, 1024, G, bid);
          EpiGlu E{WS_BF(OFF_YPRE), P.in[13] + l * 1024, WS_BF(OFF_ULRU)}; pg8::gemm_phase(lds, g, S, E); PH_END
        PH_BEGIN lru_fixup(WS_F(OFF_R3), WS_F(OFF_R3 + 64 * MiB), WS_F(OFF_SUMA), WS_F(OFF_SUMH), WS_BF(OFF_SEND), gw, NGW, lane); PH_END
        GSYNC();
        PH_BEGIN pg8::MergeOrder S; S.init(T_TOK, 2048, G, bid);
          pg8::Gemm g{WS_BF(OFF_ULRU), WS_BF(OFF_WBR), T_TOK, 2048, 1024, 1024, 1024, 0, (size_t)(OFF_SEND - OFF_ULRU), 8};
          EpiMerge E{WS_BF(OFF_GATES), WS_BF(OFF_X2)}; pg8::gemm_phase(lds, g, S, E); PH_END
        GSYNC();
        PH_BEGIN pg8::Gemm g{WS_BF(OFF_X2), WS_BF(OFF_WOUT), T_TOK, 2048, 2048, 2048, 2048}; pg8::StaticOrder S; S.init(T_TOK, 2048, G, bid); EpiResid E{hin, hres, WS_BF(OFF_XC), WS_F(OFF_PART)}; pg8::gemm_phase(lds, g, S, E); PH_END
        GSYNC();
        PH_BEGIN transpose_matrix(P.in[26] + (size_t)l * 2048 * DFF, 2048, DFF, WS_BF(OFF_R3), scr, gw, NGW, lane, P.in[25] + l * 2048); PH_END
        PH_BEGIN transpose_matrix(P.in[27] + (size_t)l * DFF * 2048, DFF, 2048, WS_BF(OFF_R3 + 32 * MiB), scr, gw, NGW, lane); PH_END
        PH_BEGIN rstd_rows(WS_F(OFF_PART), WS_F(OFF_RSTD), gt, NGT); PH_END
        GSYNC();
        PH_BEGIN pg8::Gemm g{WS_BF(OFF_XC), WS_BF(OFF_R3), T_TOK, DFF, 2048, 2048, 2048}; pg8::StaticOrder S; S.init(T_TOK, DFF, G, bid); EpiUp E{WS_BF(OFF_HDN), WS_F(OFF_RSTD)}; pg8::gemm_phase(lds, g, S, E); PH_END
        GSYNC();
        PH_BEGIN pg8::Gemm g{WS_BF(OFF_HDN), WS_BF(OFF_R3 + 32 * MiB), T_TOK, 2048, DFF, DFF, DFF}; pg8::StaticOrder S; S.init(T_TOK, 2048, G, bid); EpiResid E{hres, hres, WS_BF(OFF_X2), WS_F(OFF_PART)}; pg8::gemm_phase(lds, g, S, E); PH_END
        GSYNC();
    }
    PH_BEGIN rmsnorm_rows<true>(hres, P.in[28], hres, gw, NGW, lane); PH_END
}

extern "C" void kernel_launch(void* const* d_in, const int* in_sizes, int n_in, void* d_out, int out_size, void* d_ws, size_t ws_size, hipStream_t stream) {
    static int grid = 0;
    if (grid == 0) {
        if (n_in != 29 || out_size != T_TOK * DM || ws_size < OFF_END) { fprintf(stderr, "kernel_launch: unexpected shapes (n_in %d out %d ws %zu need %zu)\n", n_in, out_size, ws_size, (size_t)OFF_END); grid = -1; return; }
        int dev = 0, cus = 0, per_cu = 0;
        hipGetDevice(&dev); hipDeviceGetAttribute(&cus, hipDeviceAttributeMultiprocessorCount, dev);
        if (hipFuncSetAttribute((const void*)fwd_kernel, hipFuncAttributeMaxDynamicSharedMemorySize, LDS_BYTES) != hipSuccess) { fprintf(stderr, "kernel_launch: hipFuncSetAttribute failed\n"); grid = -1; return; }
        hipOccupancyMaxActiveBlocksPerMultiprocessor(&per_cu, (const void*)fwd_kernel, 512, LDS_BYTES);
        if (per_cu < 1) { fprintf(stderr, "kernel_launch: occupancy query says %d blocks per CU\n", per_cu); per_cu = 1; }
        grid = cus * 1;
        (void)hipGetLastError();
    }
    if (grid < 0) return;
    if (hipMemsetAsync((char*)d_ws + OFF_BAR, 0, 16384, stream) != hipSuccess) { fprintf(stderr, "kernel_launch: memset of barrier words failed\n"); return; }
    Params p{};
    for (int i = 0; i < 29; ++i) p.in[i] = (const float*)d_in[i];
    p.out = (float*)d_out; p.ws = (unsigned char*)d_ws;
    void* args[] = {&p};
    hipError_t e = hipLaunchCooperativeKernel((const void*)fwd_kernel, dim3(grid), dim3(512), args, LDS_BYTES, stream);
    if (e != hipSuccess) fprintf(stderr, "cooperative launch failed: %s (grid %d)\n", hipGetErrorString(e), grid);
}
```
